# Optimizing an MI355X kernel written in HIP

```python
import jax, jax.numpy as jnp
from jax import lax
import numpy as np

D_MODEL = 1024
BATCH = 8
SEQ = 4096
DEPTH = 1
DEC_BATCH = 2
DEC_SEQ = 8192
PAST_LEN = 128

GRID_W = 64
MIX_WIDTH = D_MODEL
ATTN_WIDTH = MIX_WIDTH // 2
FOURIER_WIDTH = MIX_WIDTH - ATTN_WIDTH
HEAD_DIM = 64
N_Q_HEADS = ATTN_WIDTH // HEAD_DIM
N_KV_HEADS = 2
GQA_GROUP = N_Q_HEADS // N_KV_HEADS
KV_WIDTH = N_KV_HEADS * HEAD_DIM
N_FOURIER_GROUPS = 4
FOURIER_GROUP_DIM = FOURIER_WIDTH // N_FOURIER_GROUPS
ROPE_THETA = 10000.0
Q_BLOCK = 128
EPS = 1e-6
SPLITS = [ATTN_WIDTH,
          ATTN_WIDTH + KV_WIDTH,
          ATTN_WIDTH + 2 * KV_WIDTH,
          2 * ATTN_WIDTH + 2 * KV_WIDTH,
          2 * ATTN_WIDTH + 2 * KV_WIDTH + FOURIER_WIDTH]
IN_WIDTH = 2 * ATTN_WIDTH + 2 * KV_WIDTH + 2 * FOURIER_WIDTH

kernel_name = "hymba_gqa_axialrope_fnet_encoder"


def _rmsnorm(x, w):
    xf = x.astype(jnp.float32)
    y = xf * lax.rsqrt(jnp.mean(xf * xf, axis=-1, keepdims=True) + EPS)
    return (y * w.astype(jnp.float32)).astype(x.dtype)


def _axial_rope_angles(seq_len):
    rows = seq_len // GRID_W
    row_idx, col_idx = jnp.meshgrid(jnp.arange(rows), jnp.arange(GRID_W), indexing="ij")
    row_idx = row_idx.reshape(-1).astype(jnp.float32)
    col_idx = col_idx.reshape(-1).astype(jnp.float32)
    axis_dim = HEAD_DIM // 2
    inv_freq = ROPE_THETA ** (-jnp.arange(0, axis_dim, 2, dtype=jnp.float32) / axis_dim)
    ang = jnp.concatenate([row_idx[:, None] * inv_freq, col_idx[:, None] * inv_freq], axis=-1)
    return jnp.cos(ang), jnp.sin(ang)


def _apply_rope(x, cos, sin):
    xf = x.astype(jnp.float32).reshape(*x.shape[:-1], HEAD_DIM // 2, 2)
    x1, x2 = xf[..., 0], xf[..., 1]
    c = cos[None, :, None, :]
    s = sin[None, :, None, :]
    out = jnp.stack([x1 * c - x2 * s, x1 * s + x2 * c], axis=-1).reshape(x.shape)
    return out.astype(x.dtype)


def _block_attention(q, k, v):
    B, S = q.shape[0], q.shape[1]
    nblk = S // Q_BLOCK
    qb = q.reshape(B, nblk, Q_BLOCK, N_KV_HEADS, GQA_GROUP, HEAD_DIM).transpose(1, 0, 2, 3, 4, 5)
    scale = HEAD_DIM ** -0.5

    def one_block(q_blk):
        s = jnp.einsum("bqkgd,bskd->bkgqs", q_blk, k, preferred_element_type=jnp.float32) * scale
        p = jax.nn.softmax(s, axis=-1).astype(v.dtype)
        return jnp.einsum("bkgqs,bskd->bqkgd", p, v)

    o = lax.map(one_block, qb)
    return o.transpose(1, 0, 2, 3, 4, 5).reshape(B, S, ATTN_WIDTH)


def _fourier_mix(u, w_f, b_f):
    B, S = u.shape[0], u.shape[1]
    ug = u.astype(jnp.float32).reshape(B, S, N_FOURIER_GROUPS, FOURIER_GROUP_DIM)
    mixed = jnp.real(jnp.fft.fft2(ug, axes=(1, 3), norm="ortho")).astype(u.dtype)
    out = jnp.einsum("bsgc,gcd->bsgd", mixed, w_f) + b_f
    return out.reshape(B, S, FOURIER_WIDTH)


def _mixer_layer(x, ln_w, w_in, q_norm, k_norm, w_f, b_f, w_out):
    B, S = x.shape[0], x.shape[1]
    h = _rmsnorm(x, ln_w)
    proj = jnp.einsum("bsd,de->bse", h, w_in)
    q, k, v, g_a, u_f, g_f = jnp.split(proj, SPLITS, axis=-1)
    cos, sin = _axial_rope_angles(S)
    q = _apply_rope(_rmsnorm(q.reshape(B, S, N_Q_HEADS, HEAD_DIM), q_norm), cos, sin)
    k = _apply_rope(_rmsnorm(k.reshape(B, S, N_KV_HEADS, HEAD_DIM), k_norm), cos, sin)
    v = v.reshape(B, S, N_KV_HEADS, HEAD_DIM)
    y_attn = _block_attention(q, k, v) * jax.nn.silu(g_a)
    y_four = _fourier_mix(u_f, w_f, b_f) * jax.nn.silu(g_f)
    y = jnp.concatenate([y_attn, y_four], axis=-1)
    return x + jnp.einsum("bse,ed->bsd", y, w_out)


def _trunk(x, ln_w, w_in, q_norm, k_norm, w_fourier, b_fourier, w_out, final_norm):
    for l in range(DEPTH):
        x = _mixer_layer(x, ln_w[l], w_in[l], q_norm[l], k_norm[l], w_fourier[l], b_fourier[l], w_out[l])
    return _rmsnorm(x, final_norm)


def setup_inputs(seed: int = 0) -> dict:
    key = jax.random.key(seed)
    ks = jax.random.split(key, 10)
    f32 = jnp.float32
    x_prompt = jax.random.normal(ks[0], (BATCH, SEQ, D_MODEL), f32)
    x_sample = jax.random.normal(ks[1], (DEC_BATCH, DEC_SEQ, D_MODEL), f32)
    ln_w = 1.0 + 0.02 * jax.random.normal(ks[2], (DEPTH, D_MODEL), f32)
    w_in = jax.random.normal(ks[3], (DEPTH, D_MODEL, IN_WIDTH), f32) * D_MODEL ** -0.5
    q_norm = 1.0 + 0.02 * jax.random.normal(ks[4], (DEPTH, HEAD_DIM), f32)
    k_norm = 1.0 + 0.02 * jax.random.normal(ks[5], (DEPTH, HEAD_DIM), f32)
    w_fourier = jax.random.normal(ks[6], (DEPTH, N_FOURIER_GROUPS, FOURIER_GROUP_DIM, FOURIER_GROUP_DIM), f32) * FOURIER_GROUP_DIM ** -0.5
    b_fourier = 0.02 * jax.random.normal(ks[7], (DEPTH, N_FOURIER_GROUPS, FOURIER_GROUP_DIM), f32)
    w_out = jax.random.normal(ks[8], (DEPTH, MIX_WIDTH, D_MODEL), f32) * MIX_WIDTH ** -0.5
    final_norm = 1.0 + 0.02 * jax.random.normal(ks[9], (D_MODEL,), f32)
    return {"x_prompt": x_prompt, "x_sample": x_sample, "ln_w": ln_w, "w_in": w_in,
            "q_norm": q_norm, "k_norm": k_norm, "w_fourier": w_fourier, "b_fourier": b_fourier,
            "w_out": w_out, "final_norm": final_norm}


def reference(x_prompt, x_sample, ln_w, w_in, q_norm, k_norm, w_fourier, b_fourier, w_out, final_norm):
    y_prompt = _trunk(x_prompt, ln_w, w_in, q_norm, k_norm, w_fourier, b_fourier, w_out, final_norm)
    y_sample = _trunk(x_sample, ln_w, w_in, q_norm, k_norm, w_fourier, b_fourier, w_out, final_norm)
    return (y_prompt, y_sample)
```

```cpp
#include <hip/hip_runtime.h>
#include <hip/hip_cooperative_groups.h>
#include <cstdio>
#include <cstdint>
namespace cg = cooperative_groups;

typedef unsigned short u16;
typedef short bf16x8 __attribute__((ext_vector_type(8)));
typedef float f32x16 __attribute__((ext_vector_type(16)));
typedef float f32x4 __attribute__((ext_vector_type(4)));
typedef float f32x2 __attribute__((ext_vector_type(2)));
typedef unsigned u32x4 __attribute__((ext_vector_type(4)));
typedef unsigned u32x2 __attribute__((ext_vector_type(2)));
typedef __bf16 bf16x2_t __attribute__((ext_vector_type(2)));
#define LAS __attribute__((address_space(3)))

constexpr int DM = 1024, NTOK = 49152, NPROMPT = 32768, N1 = 2816, WIN_LD = 2304;
constexpr float EPS = 1e-6f;
constexpr float QSCALE = 0.125f * 1.4426950408889634f;
constexpr size_t MiB = 1u << 20, KiB = 1u << 10;
constexpr size_t OFF_XB = 0;
constexpr size_t OFF_RINV = 96 * MiB;
constexpr size_t OFF_ROWSS = 96 * MiB + 256 * KiB;
constexpr size_t OFF_ROPE = 96 * MiB + 512 * KiB;
constexpr size_t OFF_TW = 96 * MiB + 576 * KiB;
constexpr size_t OFF_F1A = 96 * MiB + 640 * KiB;
constexpr size_t OFF_F1B = 96 * MiB + 704 * KiB;
constexpr size_t OFF_F2 = 96 * MiB + 768 * KiB;
constexpr size_t OFF_MF = 97 * MiB;
constexpr size_t OFF_W1T = 98 * MiB;
constexpr size_t OFF_WOT = 104 * MiB;
constexpr size_t OFF_Q = 112 * MiB;
constexpr size_t OFF_K = 160 * MiB;
constexpr size_t OFF_VT = 172 * MiB;
constexpr size_t OFF_GA = 184 * MiB;
constexpr size_t OFF_GF = 232 * MiB;
constexpr size_t OFF_YB = 280 * MiB;
constexpr size_t OFF_BAR = 96 * MiB + 832 * KiB;
constexpr int LDS_MAIN = 131072, LDS_BYTES = LDS_MAIN + 64;
constexpr int NTHR = 512, NWAVE = 8;

struct Params {
  const float *x_prompt, *x_sample, *ln_w, *w_in, *q_norm, *k_norm, *w_f, *b_f, *w_out, *final_norm;
  float* out; unsigned char* ws;
};

__device__ __forceinline__ unsigned cvtpk(float lo, float hi) { f32x2 v = {lo, hi}; bf16x2_t b = __builtin_convertvector(v, bf16x2_t); return __builtin_bit_cast(unsigned, b); }
__device__ __forceinline__ float bf2f(unsigned short h) { return __uint_as_float(((unsigned)h) << 16); }
__device__ __forceinline__ float silu(float v) { return v * __builtin_amdgcn_rcpf(1.f + __builtin_amdgcn_exp2f(-1.4426950408889634f * v)); }
__device__ __forceinline__ void seq_info(int seq, int& seqbase, int& S) { if (seq < 8) { seqbase = seq * 4096; S = 4096; } else { seqbase = NPROMPT + (seq - 8) * 8192; S = 8192; } }
__device__ __forceinline__ void seq_of_row(int row, int& seqbase, int& S) { if (row < NPROMPT) { seqbase = row & ~4095; S = 4096; } else { seqbase = NPROMPT + ((row - NPROMPT) & ~8191); S = 8192; } }
__device__ __forceinline__ f32x16 zero16() { f32x16 z; for (int i = 0; i < 16; ++i) z[i] = 0.f; return z; }


#define XB_TMO      128
#define XB_XCNT(j)  (256  + 64 * (j))
#define XB_XSUB(j)  (1280 + 64 * (j))
#define XB_XGEN(j)  (2304 + 64 * (j))
#define XB_TOP      3328
#define XB_TOPGEN   3392
#define XCD_BAR_WORDS 3456
#define XB_SPIN_CAP (1u << 18)
__device__ __forceinline__ unsigned xb_ld(unsigned* p)              { return __hip_atomic_load(p, __ATOMIC_RELAXED, __HIP_MEMORY_SCOPE_AGENT); }
__device__ __forceinline__ unsigned xb_add(unsigned* p, unsigned v) { return __hip_atomic_fetch_add(p, v, __ATOMIC_RELAXED, __HIP_MEMORY_SCOPE_AGENT); }
__device__ __forceinline__ unsigned xb_xcc_id() { return (unsigned)__builtin_amdgcn_s_getreg((3 << 11) | 20) & 0xFu; }
#define XB_SPIN(cond, bar) do { unsigned _sp = 0; while (cond) { __builtin_amdgcn_s_sleep(1); \
    if ((++_sp & 255u) == 0u) { if (xb_ld(&(bar)[XB_TMO])) break; if (_sp > XB_SPIN_CAP) { atomicAdd(&(bar)[XB_TMO], 1u); break; } } } } while (0)
struct XcdBarrier { unsigned* bar; unsigned x; volatile LAS unsigned* st; };
__device__ __forceinline__ XcdBarrier xcd_barrier_post(unsigned* bar, volatile LAS unsigned* st) {
  XcdBarrier b; b.bar = bar; b.x = xb_xcc_id(); b.st = st;
  if (threadIdx.x == 0) (void)xb_add(&bar[XB_XCNT(b.x)], 1u);
  return b;
}
__device__ __forceinline__ void xcd_barrier_complete(unsigned* bar, unsigned x, unsigned& nloc, unsigned& nx) {
  const unsigned G = gridDim.x * gridDim.y * gridDim.z;
  unsigned sum, cnt, mine, sp = 0u;
  for (;;) {
    sum = 0u; cnt = 0u; mine = 0u;
#pragma unroll
    for (unsigned j = 0; j < 16; ++j) { const unsigned c = xb_ld(&bar[XB_XCNT(j)]); sum += c; cnt += (c > 0u) ? 1u : 0u; mine = (j == x) ? c : mine; }
    if (sum == G) break;
    __builtin_amdgcn_s_sleep(1);
    if ((++sp & 255u) == 0u) { if (xb_ld(&bar[XB_TMO])) break; if (sp > XB_SPIN_CAP) { atomicAdd(&bar[XB_TMO], 1u); break; } }
  }
  nloc = mine > 0u ? mine : 1u; nx = cnt > 0u ? cnt : 1u;
}
__device__ __forceinline__ void xcd_barrier(const XcdBarrier& b) {
  asm volatile("s_waitcnt vmcnt(0)" ::: "memory");
  __syncthreads();
  if (threadIdx.x == 0) {
    unsigned* bar = b.bar;
    __builtin_amdgcn_s_waitcnt(0);
    unsigned nloc = b.st[0], nx = b.st[1];
    if (nloc == 0u) { xcd_barrier_complete(bar, b.x, nloc, nx); b.st[0] = nloc; b.st[1] = nx; }
    const unsigned old = xb_add(&bar[XB_XSUB(b.x)], 1u);
    const unsigned gen = old / nloc;
    if (old + 1u == (gen + 1u) * nloc) {
      __builtin_amdgcn_fence(__ATOMIC_RELEASE, "agent");
      asm volatile("s_waitcnt vmcnt(0)" ::: "memory");
      const unsigned og = xb_add(&bar[XB_TOP], 1u);
      const unsigned tg = og / nx;
      if (og + 1u == (tg + 1u) * nx) xb_add(&bar[XB_TOPGEN], 1u);
      else XB_SPIN(xb_ld(&bar[XB_TOPGEN]) == tg, bar);
      __builtin_amdgcn_fence(__ATOMIC_ACQUIRE, "agent");
      xb_add(&bar[XB_XGEN(b.x)], 1u);
      asm volatile("s_waitcnt vmcnt(0)" ::: "memory");
    } else {
      XB_SPIN(xb_ld(&bar[XB_XGEN(b.x)]) == gen, bar);
      __builtin_amdgcn_fence(__ATOMIC_ACQUIRE, "agent");
      asm volatile("s_waitcnt vmcnt(0)" ::: "memory");
    }
  }
  __syncthreads();
}

__device__ __forceinline__ void gemm_mainloop(LAS unsigned char* lds, const u16* Xg, const u16* Yg, f32x16 (&acc)[4][2], int tid) {
  const int lane = tid & 63, wid = __builtin_amdgcn_readfirstlane(tid >> 6), wy = wid >> 2, wx = wid & 3, l32 = lane & 31, hi = lane >> 5;
  const int drow = wid * 16 + (lane >> 2), dch = (lane & 3) ^ ((drow >> 2) & 3);
  const u16* xp = Xg + (size_t)drow * 1024 + dch * 8;
  const u16* yp = Yg + (size_t)drow * 1024 + dch * 8;
  const int sw = (l32 >> 2) & 3;
  const unsigned xbase = (wy * 128 + l32) * 64, ybase = 16384 + (wx * 64 + l32) * 64;
  const unsigned ldsw = (unsigned)wid * 1024u;
#define GEMM_DMA(j_) do { const unsigned so_ = (unsigned)(((j_) & 3) * 32768); _Pragma("unroll") for (int i_ = 0; i_ < 2; ++i_) { \
    __builtin_amdgcn_global_load_lds((const unsigned*)(xp + (size_t)i_ * 128 * 1024 + (j_) * 32), (LAS unsigned*)(lds + so_ + ldsw + i_ * 8192), 16, 0, 0); \
    __builtin_amdgcn_global_load_lds((const unsigned*)(yp + (size_t)i_ * 128 * 1024 + (j_) * 32), (LAS unsigned*)(lds + so_ + 16384 + ldsw + i_ * 8192), 16, 0, 0); } } while (0)
  GEMM_DMA(0); GEMM_DMA(1); GEMM_DMA(2);
#pragma unroll 4
  for (int j = 0; j < 32; ++j) {
    const unsigned bo = (unsigned)((j & 3) * 32768);
    if (j < 30) asm volatile("s_waitcnt vmcnt(8) lgkmcnt(0)" ::: "memory");
    else if (j == 30) asm volatile("s_waitcnt vmcnt(4) lgkmcnt(0)" ::: "memory");
    else asm volatile("s_waitcnt vmcnt(0) lgkmcnt(0)" ::: "memory");
    __builtin_amdgcn_s_barrier();
    asm volatile("" ::: "memory");
    if (j + 3 < 32) GEMM_DMA(j + 3);
#pragma unroll
    for (int ks = 0; ks < 2; ++ks) {
      const unsigned co = (unsigned)(((ks * 2 + hi) ^ sw) << 4);
      bf16x8 xf[4], yf[2];
#pragma unroll
      for (int ni = 0; ni < 2; ++ni) yf[ni] = *(const LAS bf16x8*)(lds + bo + ybase + ni * 2048 + co);
#pragma unroll
      for (int mi = 0; mi < 4; ++mi) xf[mi] = *(const LAS bf16x8*)(lds + bo + xbase + mi * 2048 + co);
#pragma unroll
      for (int mi = 0; mi < 4; ++mi)
#pragma unroll
        for (int ni = 0; ni < 2; ++ni) acc[mi][ni] = __builtin_amdgcn_mfma_f32_32x32x16_bf16(xf[mi], yf[ni], acc[mi][ni], 0, 0, 0);
    }
  }
#undef GEMM_DMA
  asm volatile("s_waitcnt lgkmcnt(0)" ::: "memory");
  __builtin_amdgcn_s_barrier();
  asm volatile("" ::: "memory");
}


__device__ __forceinline__ void stage_put(LAS unsigned char* lds, int row, int col, u32x2 w) { *(LAS u32x2*)(lds + row * 512 + (((col >> 2) ^ (row & 63)) << 3)) = w; }
__device__ __forceinline__ void stage_flush(LAS unsigned char* lds, u16* dst, int ld, int wid, int lane) {
  __syncthreads();
  const int c = lane & 31, hh = lane >> 5;
#pragma unroll 2
  for (int rd = 0; rd < 16; ++rd) {
    const int r = rd * 16 + wid * 2 + hh;
    u32x4 v = *(const LAS u32x4*)(lds + r * 512 + ((c ^ ((r & 63) >> 1)) << 4));
    if (r & 1) { u32x4 t; t.x = v.z; t.y = v.w; t.z = v.x; t.w = v.y; v = t; }
    __builtin_nontemporal_store(v, (u32x4*)(dst + (size_t)r * ld + c * 8));
  }
  __syncthreads();
}

__global__ void __launch_bounds__(512, 2) fwd_kernel(Params p) {
  extern __shared__ __attribute__((aligned(16))) unsigned char smem[];
  LAS unsigned char* lds = (LAS unsigned char*)smem;
  cg::grid_group grid = cg::this_grid();
  if (p.ws == nullptr) grid.sync();
  volatile LAS unsigned* misc = (volatile LAS unsigned*)(lds + LDS_MAIN);
  if (threadIdx.x < 16) misc[threadIdx.x] = 0u;
  __syncthreads();
  const XcdBarrier gbar = xcd_barrier_post((unsigned*)(p.ws + OFF_BAR), misc);
  const int tid = threadIdx.x, lane = tid & 63, wid = __builtin_amdgcn_readfirstlane(tid >> 6), l32 = lane & 31, hi = lane >> 5;
  const int G = gridDim.x;
  const int vb = (G % 8 == 0) ? (int)((blockIdx.x % 8) * (G / 8) + blockIdx.x / 8) : (int)blockIdx.x;
  unsigned char* ws = p.ws;
  u16* xb = (u16*)(ws + OFF_XB); u16* y1 = (u16*)(ws + OFF_XB);
  float* rinv = (float*)(ws + OFF_RINV); float* rowss = (float*)(ws + OFF_ROWSS);
  float* rope = (float*)(ws + OFF_ROPE); float* tw = (float*)(ws + OFF_TW);
  u16* f1a = (u16*)(ws + OFF_F1A); u16* f1b = (u16*)(ws + OFF_F1B); u16* f2t = (u16*)(ws + OFF_F2);
  float* mf = (float*)(ws + OFF_MF);
  u16* w1t = (u16*)(ws + OFF_W1T); u16* wot = (u16*)(ws + OFF_WOT);
  u16* qb = (u16*)(ws + OFF_Q); u16* kb = (u16*)(ws + OFF_K); u16* vt = (u16*)(ws + OFF_VT);
  u16* ga = (u16*)(ws + OFF_GA); u16* gf = (u16*)(ws + OFF_GF); u16* yb = (u16*)(ws + OFF_YB);
  u16* yw = (u16*)(ws + OFF_GA);
  u16* zt = (u16*)p.out;
  unsigned* pcnt = (unsigned*)(ws + OFF_BAR) + 3584;
  const int gtid = blockIdx.x * NTHR + tid, NT_ = G * NTHR;
  const int gw = blockIdx.x * NWAVE + wid, NW = G * NWAVE;

  for (int row = gw; row < NTOK; row += NW) {
    const float* xr = (row < NPROMPT) ? p.x_prompt + (size_t)row * DM : p.x_sample + (size_t)(row - NPROMPT) * DM;
    f32x4 v[4]; float ss = 0.f;
#pragma unroll
    for (int j = 0; j < 4; ++j) { v[j] = __builtin_nontemporal_load((const f32x4*)xr + lane + 64 * j); ss += v[j].x * v[j].x + v[j].y * v[j].y + v[j].z * v[j].z + v[j].w * v[j].w; }
#pragma unroll
    for (int o = 1; o < 64; o <<= 1) ss += __shfl_xor(ss, o);
    u32x2* o8 = (u32x2*)(xb + (size_t)row * DM);
#pragma unroll
    for (int j = 0; j < 4; ++j) { u32x2 w; w.x = cvtpk(v[j].x, v[j].y); w.y = cvtpk(v[j].z, v[j].w); o8[lane + 64 * j] = w; }
    if (lane == 0) rinv[row] = rsqrtf(ss * (1.f / DM) + EPS);
  }
  for (int i = gtid; i < 192 * 16; i += NT_) {
    const int pr = i >> 4, j = i & 15; const float pos = (float)(pr < 128 ? pr : pr - 128);
    const float invf = powf(10000.f, -(float)j / 16.f); float s, c; sincosf(pos * invf, &s, &c);
    rope[2 * i] = c; rope[2 * i + 1] = s;
  }
  for (int i = gtid; i < 8192; i += NT_) { float s, c; sincospif((float)i / 4096.f, &s, &c); tw[2 * i] = c; tw[2 * i + 1] = s; }
  for (int i = gtid; i < 8192 + 32768 + 8192; i += NT_) {
    float val; u16* dst;
    if (i < 8192 + 32768) {
      const bool big = i >= 8192; const int e = big ? i - 8192 : i; const int H = big ? 128 : 64, KS = big ? 8 : 4;
      const int j = e & 7, ln = (e >> 3) & 63, cs = (e >> 9) & 1, nt = (e >> 10) & 1, rest = e >> 11; const int ks = rest % KS, nb = rest / KS;
      const int sb = nb * 64 + nt * 32 + (ln & 31), th = ks * 16 + 8 * (j >> 2) + 4 * (ln >> 5) + (j & 3);
      float s, c; sincospif((float)((sb * th) & (H - 1)) * (2.f / (float)H), &s, &c); val = cs ? s : c; dst = (big ? f1b : f1a) + e;
    } else {
      const int e = i - 8192 - 32768; const int j = e & 7, ln = (e >> 3) & 63, nt = (e >> 9) & 1, ks = e >> 10;
      const int sa = nt * 32 + (ln & 31), kidx = ks * 16 + 8 * (ln >> 5) + j, part = kidx >> 6, tl = kidx & 63;
      float s, c; sincospif((float)((sa * tl) & 63) * (1.f / 32.f), &s, &c); val = part ? s : c; dst = f2t + e;
    }
    *dst = (u16)(cvtpk(val, 0.f) & 0xffffu);
  }
  for (int i = gtid; i < 128 * 1792; i += NT_) {
    const int k8 = i / 1792, jn = i % 1792; const int n = jn < 1280 ? jn : jn + 1024, src = jn < 1280 ? jn : jn + 512;
    float v[8];
#pragma unroll
    for (int e = 0; e < 8; ++e) v[e] = p.ln_w[k8 * 8 + e] * p.w_in[(size_t)(k8 * 8 + e) * WIN_LD + src];
    u32x4 w; w.x = cvtpk(v[0], v[1]); w.y = cvtpk(v[2], v[3]); w.z = cvtpk(v[4], v[5]); w.w = cvtpk(v[6], v[7]);
    *(u32x4*)(w1t + (size_t)n * DM + k8 * 8) = w;
  }
  for (int i = gtid; i < 128 * 1024; i += NT_) {
    const int k8 = i >> 10, n = i & 1023; float v[8];
#pragma unroll
    for (int e = 0; e < 8; ++e) v[e] = p.w_out[(size_t)(k8 * 8 + e) * DM + n];
    u32x4 w; w.x = cvtpk(v[0], v[1]); w.y = cvtpk(v[2], v[3]); w.z = cvtpk(v[4], v[5]); w.w = cvtpk(v[6], v[7]);
    *(u32x4*)(wot + (size_t)n * DM + k8 * 8) = w;
  }
  for (int i = gtid; i < 4 * 128 * 128; i += NT_) {
    const int c = i & 127, cp = (i >> 7) & 127, g = i >> 14; float a1 = 0.f, a2 = 0.f;
    for (int j = 0; j < 128; ++j) { float s, cc; sincospif((float)((cp * j) & 127) * (1.f / 64.f), &s, &cc); const float w = p.w_f[(size_t)(g * 128 + j) * 128 + c]; a1 += cc * w; a2 += s * w; }
    mf[i] = a1 * 0.08838834764831845f; mf[65536 + i] = -a2 * 0.08838834764831845f;
  }
  xcd_barrier(gbar);

  for (int u = blockIdx.x; u < 128; u += G) {
    const int g = u >> 5, d0 = (u & 31) * 32;
    LAS float* wt = (LAS float*)lds;
#pragma unroll
    for (int i = 0; i < 8; ++i) { const int idx = tid + NTHR * i, dd = idx >> 7, cc = idx & 127; wt[cc * 32 + dd] = p.w_in[(size_t)(d0 + dd) * WIN_LD + 1280 + g * 128 + cc] * p.ln_w[d0 + dd]; }
    __syncthreads();
    const int c = tid & 127, q4 = tid >> 7;
    float a1[8], a2[8];
#pragma unroll
    for (int e = 0; e < 8; ++e) { a1[e] = 0.f; a2[e] = 0.f; }
    for (int cp = 0; cp < 128; ++cp) {
      const float m1 = mf[(g * 128 + cp) * 128 + c], m2 = mf[65536 + (g * 128 + cp) * 128 + c];
      const f32x4 w0 = *(const LAS f32x4*)(wt + cp * 32 + q4 * 8), w1 = *(const LAS f32x4*)(wt + cp * 32 + q4 * 8 + 4);
      a1[0] += w0.x * m1; a1[1] += w0.y * m1; a1[2] += w0.z * m1; a1[3] += w0.w * m1; a1[4] += w1.x * m1; a1[5] += w1.y * m1; a1[6] += w1.z * m1; a1[7] += w1.w * m1;
      a2[0] += w0.x * m2; a2[1] += w0.y * m2; a2[2] += w0.z * m2; a2[3] += w0.w * m2; a2[4] += w1.x * m2; a2[5] += w1.y * m2; a2[6] += w1.z * m2; a2[7] += w1.w * m2;
    }
    u32x4 w; w.x = cvtpk(a1[0], a1[1]); w.y = cvtpk(a1[2], a1[3]); w.z = cvtpk(a1[4], a1[5]); w.w = cvtpk(a1[6], a1[7]);
    *(u32x4*)(w1t + (size_t)(1280 + g * 128 + c) * DM + d0 + q4 * 8) = w;
    w.x = cvtpk(a2[0], a2[1]); w.y = cvtpk(a2[2], a2[3]); w.z = cvtpk(a2[4], a2[5]); w.w = cvtpk(a2[6], a2[7]);
    *(u32x4*)(w1t + (size_t)(1792 + g * 128 + c) * DM + d0 + q4 * 8) = w;
    __syncthreads();
  }
  xcd_barrier(gbar);

  {
    const int wy = wid >> 2, wx = wid & 3;
    for (int u = vb; u < 192 * 11; u += G) {
      const int mt = u / 11, nt = u % 11;
      const bool swapped = !(nt >= 5 && nt < 9);
      const u16* At = xb + (size_t)mt * 256 * DM; const u16* Wt = w1t + (size_t)nt * 256 * DM;
      f32x16 acc[4][2];
#pragma unroll
      for (int a = 0; a < 4; ++a)
#pragma unroll
        for (int b = 0; b < 2; ++b) acc[a][b] = zero16();
      gemm_mainloop(lds, swapped ? Wt : At, swapped ? At : Wt, acc, tid);
      const int rowbase = mt * 256;
      int seqbase, S; seq_of_row(rowbase, seqbase, S);
      if (swapped) {
        if (nt < 2 || (nt == 2 && wy == 0)) {
          const bool isq = nt < 2;
          const float* nw = isq ? p.q_norm : p.k_norm;
          const float osc = isq ? QSCALE : 1.f;
#pragma unroll
          for (int ni = 0; ni < 2; ++ni) {
            const int token = rowbase + wx * 64 + ni * 32 + l32, pos = token - seqbase;
            const float ri = rinv[token];
#pragma unroll
            for (int hp = 0; hp < 2; ++hp) {
              float ss = 0.f;
#pragma unroll
              for (int mm = 0; mm < 2; ++mm)
#pragma unroll
                for (int r = 0; r < 16; ++r) { const float v = acc[hp * 2 + mm][ni][r] * ri; acc[hp * 2 + mm][ni][r] = v; ss += v * v; }
              ss += __shfl_xor(ss, 32);
              const float rn = rsqrtf(ss * (1.f / 64.f) + EPS);
              const int head = isq ? (nt * 4 + wy * 2 + hp) : hp;
#pragma unroll
              for (int mm = 0; mm < 2; ++mm) {
                const float posv = (float)((mm == 0) ? (pos >> 6) : (pos & 63));
#pragma unroll
                for (int r4 = 0; r4 < 4; ++r4) {
                  const int d = mm * 32 + 8 * r4 + 4 * hi;
                  const f32x4 wv = *(const f32x4*)(nw + d);
                  f32x4 cs;
                  { float pv2 = posv; asm volatile("" : "+v"(pv2));
                    const float jf = (float)(4 * r4 + 2 * hi);
                    const float rv0 = pv2 * (__builtin_amdgcn_exp2f(-0.8304820237218406f * jf) * 0.15915494309189535f), rv1 = pv2 * (__builtin_amdgcn_exp2f(-0.8304820237218406f * (jf + 1.f)) * 0.15915494309189535f);
                    cs.x = __builtin_amdgcn_cosf(rv0); cs.y = __builtin_amdgcn_sinf(rv0); cs.z = __builtin_amdgcn_cosf(rv1); cs.w = __builtin_amdgcn_sinf(rv1); }
                  const float x0 = acc[hp * 2 + mm][ni][r4 * 4 + 0] * rn * wv.x, x1 = acc[hp * 2 + mm][ni][r4 * 4 + 1] * rn * wv.y;
                  const float x2 = acc[hp * 2 + mm][ni][r4 * 4 + 2] * rn * wv.z, x3 = acc[hp * 2 + mm][ni][r4 * 4 + 3] * rn * wv.w;
                  const float o0 = (x0 * cs.x - x1 * cs.y) * osc, o1 = (x0 * cs.y + x1 * cs.x) * osc;
                  const float o2 = (x2 * cs.z - x3 * cs.w) * osc, o3 = (x2 * cs.w + x3 * cs.z) * osc;
                  u32x2 w; w.x = cvtpk(o0, o1); w.y = cvtpk(o2, o3);
                  if (isq) *(u32x2*)(qb + (size_t)token * 512 + head * 64 + d) = w;
                  else *(u32x2*)(kb + (size_t)token * 128 + head * 64 + d) = w;
                }
              }
            }
          }
        } else if (nt == 2) {
          u16* dst = vt + (size_t)seqbase * 128;
#pragma unroll
          for (int ni = 0; ni < 2; ++ni) {
            const int token = rowbase + wx * 64 + ni * 32 + l32, pos0 = token - seqbase;
            const int pos = (pos0 & ~12) | ((pos0 & 4) << 1) | ((pos0 & 8) >> 1);
            const float ri = rinv[token];
            u16* pv = dst + (size_t)(4 * hi) * S + pos;
#pragma unroll
            for (int mi = 0; mi < 4; ++mi)
#pragma unroll
              for (int r4 = 0; r4 < 4; ++r4) {
#pragma unroll
                for (int e = 0; e < 4; ++e) { *pv = (u16)(cvtpk(acc[mi][ni][r4 * 4 + e] * ri, 0.f) & 0xffffu); pv += S; asm volatile("" : "+v"(pv)); }
                pv += 4 * S; asm volatile("" : "+v"(pv));
              }
          }
        } else {
          u16* gdst = (nt < 5) ? ga : gf; const int cb = ((nt < 5) ? (nt - 3) : (nt - 9)) * 256 + wy * 128;
#pragma unroll
          for (int ni = 0; ni < 2; ++ni) {
            const int token = rowbase + wx * 64 + ni * 32 + l32; const float ri = rinv[token];
#pragma unroll
            for (int mi = 0; mi < 4; ++mi)
#pragma unroll
              for (int r4 = 0; r4 < 4; ++r4) {
                const float v0 = silu(acc[mi][ni][r4 * 4 + 0] * ri), v1 = silu(acc[mi][ni][r4 * 4 + 1] * ri), v2 = silu(acc[mi][ni][r4 * 4 + 2] * ri), v3 = silu(acc[mi][ni][r4 * 4 + 3] * ri);
                u32x2 w; w.x = cvtpk(v0, v1); w.y = cvtpk(v2, v3);
                stage_put(lds, wx * 64 + ni * 32 + l32, wy * 128 + mi * 32 + 8 * r4 + 4 * hi, w);
              }
          }
          stage_flush(lds, gdst + (size_t)rowbase * 512 + (cb - wy * 128), 512, wid, lane);
        }
      } else {
        u16* dst = zt + (size_t)seqbase * 1024 + (size_t)(nt - 5) * 256 * S;
#pragma unroll
        for (int mi = 0; mi < 4; ++mi)
#pragma unroll
          for (int r4 = 0; r4 < 4; ++r4) {
            const int token = rowbase + wy * 128 + mi * 32 + 8 * r4 + 4 * hi;
            const f32x4 ri = *(const f32x4*)(rinv + token);
#pragma unroll
            for (int ni = 0; ni < 2; ++ni) {
              const int ch = wx * 64 + ni * 32 + l32;
              u32x2 w; w.x = cvtpk(acc[mi][ni][r4 * 4 + 0] * ri.x, acc[mi][ni][r4 * 4 + 1] * ri.y); w.y = cvtpk(acc[mi][ni][r4 * 4 + 2] * ri.z, acc[mi][ni][r4 * 4 + 3] * ri.w);
              stage_put(lds, ch, wy * 128 + mi * 32 + 8 * r4 + 4 * hi, w);
            }
          }
        stage_flush(lds, dst + (rowbase - seqbase), S, wid, lane);
      }
    }
  }
  xcd_barrier(gbar);

  for (int u = gw; u < 6144; u += NW) {
    int seq, c, nb;
    if (u < 2048) { seq = 8 + (u >> 10); c = (u & 1023) >> 1; nb = u & 1; } else { const int v = u - 2048; seq = v >> 9; c = v & 511; nb = 0; }
    int seqbase, S; seq_info(seq, seqbase, S);
    const int KS = S >> 10;
    const u16* ftab = (S == 4096) ? f1a : f1b;
    const u16* zre = zt + (size_t)seqbase * 1024 + (size_t)c * S;
    const u16* zim = zre + (size_t)512 * S;
    f32x16 yr[2][2], yi[2][2];
#pragma unroll
    for (int a = 0; a < 2; ++a)
#pragma unroll
      for (int b = 0; b < 2; ++b) { yr[a][b] = zero16(); yi[a][b] = zero16(); }
    bf16x8 idf[2];
#pragma unroll
    for (int h2 = 0; h2 < 2; ++h2) { u32x4 t;
      const int b = l32 - 16 * h2 - 8 * hi;
      t.x = (b == 0 ? 0x3f80u : 0u) | (b == 1 ? 0x3f800000u : 0u); t.y = (b == 2 ? 0x3f80u : 0u) | (b == 3 ? 0x3f800000u : 0u);
      t.z = (b == 4 ? 0x3f80u : 0u) | (b == 5 ? 0x3f800000u : 0u); t.w = (b == 6 ? 0x3f80u : 0u) | (b == 7 ? 0x3f800000u : 0u);
      idf[h2] = __builtin_bit_cast(bf16x8, t); }
    for (int mt = 0; mt < (KS >> 1); ++mt) {
      bf16x8 zr[2][2], zi[2][2];
      {
        const u16* pr = zre + (size_t)(mt * 32 + l32) * 64 + 8 * hi;
        const u16* pi = zim + (size_t)(mt * 32 + l32) * 64 + 8 * hi;
        bf16x8 ar[4], ai[4];
#pragma unroll
        for (int kk = 0; kk < 4; ++kk) { ar[kk] = *(const bf16x8*)(pr + kk * 16); ai[kk] = *(const bf16x8*)(pi + kk * 16); }
#pragma unroll
        for (int nt = 0; nt < 2; ++nt) {
          f32x16 dr = __builtin_amdgcn_mfma_f32_32x32x16_bf16(ar[2 * nt], idf[0], zero16(), 0, 0, 0);
          dr = __builtin_amdgcn_mfma_f32_32x32x16_bf16(ar[2 * nt + 1], idf[1], dr, 0, 0, 0);
          f32x16 di = __builtin_amdgcn_mfma_f32_32x32x16_bf16(ai[2 * nt], idf[0], zero16(), 0, 0, 0);
          di = __builtin_amdgcn_mfma_f32_32x32x16_bf16(ai[2 * nt + 1], idf[1], di, 0, 0, 0);
#pragma unroll
          for (int k2 = 0; k2 < 2; ++k2) {
            u32x4 a, b; a.x = cvtpk(dr[k2 * 8 + 0], dr[k2 * 8 + 1]); a.y = cvtpk(dr[k2 * 8 + 2], dr[k2 * 8 + 3]); a.z = cvtpk(dr[k2 * 8 + 4], dr[k2 * 8 + 5]); a.w = cvtpk(dr[k2 * 8 + 6], dr[k2 * 8 + 7]);
            b.x = cvtpk(di[k2 * 8 + 0], di[k2 * 8 + 1]); b.y = cvtpk(di[k2 * 8 + 2], di[k2 * 8 + 3]); b.z = cvtpk(di[k2 * 8 + 4], di[k2 * 8 + 5]); b.w = cvtpk(di[k2 * 8 + 6], di[k2 * 8 + 7]);
            zr[nt][k2] = __builtin_bit_cast(bf16x8, a); zi[nt][k2] = __builtin_bit_cast(bf16x8, b);
          }
        }
      }
#pragma unroll
      for (int k2 = 0; k2 < 2; ++k2) {
        const int ks = mt * 2 + k2;
        bf16x8 fc[2], fs[2], fn[2];
#pragma unroll
        for (int ni = 0; ni < 2; ++ni) {
          const size_t fo = ((size_t)(((nb * KS + ks) * 2 + ni) * 2) * 64 + lane) * 8;
          fc[ni] = *(const bf16x8*)(ftab + fo); fs[ni] = *(const bf16x8*)(ftab + fo + 512);
          u32x4 t = __builtin_bit_cast(u32x4, fs[ni]); t.x ^= 0x80008000u; t.y ^= 0x80008000u; t.z ^= 0x80008000u; t.w ^= 0x80008000u; fn[ni] = __builtin_bit_cast(bf16x8, t);
        }
#pragma unroll
        for (int mi = 0; mi < 2; ++mi)
#pragma unroll
          for (int ni = 0; ni < 2; ++ni) {
            yr[mi][ni] = __builtin_amdgcn_mfma_f32_32x32x16_bf16(zr[mi][k2], fc[ni], yr[mi][ni], 0, 0, 0);
            yr[mi][ni] = __builtin_amdgcn_mfma_f32_32x32x16_bf16(zi[mi][k2], fs[ni], yr[mi][ni], 0, 0, 0);
            yi[mi][ni] = __builtin_amdgcn_mfma_f32_32x32x16_bf16(zi[mi][k2], fc[ni], yi[mi][ni], 0, 0, 0);
            yi[mi][ni] = __builtin_amdgcn_mfma_f32_32x32x16_bf16(zr[mi][k2], fn[ni], yi[mi][ni], 0, 0, 0);
          }
      }
    }
    const int tsh = (S == 4096) ? 1 : 0;
    u16* ybase = y1 + (size_t)seqbase * 1024;
    LAS unsigned char* wl = lds + wid * 16384;
#pragma unroll
    for (int ni = 0; ni < 2; ++ni) {
      const int sb = nb * 64 + ni * 32 + l32;
#pragma unroll
      for (int mi = 0; mi < 2; ++mi)
#pragma unroll
        for (int r4 = 0; r4 < 4; ++r4) {
          const int tl0 = mi * 32 + 8 * r4 + 4 * hi;
          float orr[4], oii[4];
#pragma unroll
          for (int e = 0; e < 4; ++e) {
            const int idx = ((sb * (tl0 + e)) << tsh) & 8191;
            const float rev = (float)idx * (1.f / 8192.f);
            const float tc = __builtin_amdgcn_cosf(rev), ts = __builtin_amdgcn_sinf(rev);
            const float a = yr[mi][ni][r4 * 4 + e], b = yi[mi][ni][r4 * 4 + e];
            orr[e] = a * tc + b * ts; oii[e] = b * tc - a * ts;
          }
          const int rl = ni * 32 + l32;
          u32x2 w; w.x = cvtpk(orr[0], orr[1]); w.y = cvtpk(orr[2], orr[3]); *(LAS u32x2*)(wl + rl * 256 + ((((tl0 >> 2)) ^ (rl & 31)) << 3)) = w;
          w.x = cvtpk(oii[0], oii[1]); w.y = cvtpk(oii[2], oii[3]); *(LAS u32x2*)(wl + rl * 256 + (((16 + (tl0 >> 2)) ^ (rl & 31)) << 3)) = w;
        }
    }
    {
      u16* yblk = ybase + ((size_t)c * (S >> 6) + nb * 64) * 128;
      const int cc = lane & 15, rq = lane >> 4;
#pragma unroll 4
      for (int rd = 0; rd < 16; ++rd) {
        const int r = rd * 4 + rq;
        u32x4 v = *(const LAS u32x4*)(wl + r * 256 + ((cc ^ ((r & 31) >> 1)) << 4));
        if (r & 1) { u32x4 t; t.x = v.z; t.y = v.w; t.z = v.x; t.w = v.y; v = t; }
        __builtin_nontemporal_store(v, (u32x4*)(yblk + (size_t)r * 128 + cc * 8));
      }
    }
  }
  xcd_barrier(gbar);

  float att_B; bool att_online;
  { float wq = fabsf(p.q_norm[lane]), wk = fabsf(p.k_norm[lane]);
#pragma unroll
    for (int o = 1; o < 64; o <<= 1) { wq = fmaxf(wq, __shfl_xor(wq, o)); wk = fmaxf(wk, __shfl_xor(wk, o)); }
    att_B = __uint_as_float(__builtin_amdgcn_readfirstlane(__float_as_uint(64.f * QSCALE * wq * wk))); att_online = !(att_B < 40.f); }
  for (int u = vb; u < 3072; u += G) {
    if (u < 1536) {
      int seq, qblk, h;
      if (u < 512) { seq = 8 + (u >> 8); const int rem = u & 255; qblk = rem >> 3; h = rem & 7; } else { const int v = u - 512; seq = v >> 7; const int rem = v & 127; qblk = rem >> 3; h = rem & 7; }
      int seqbase, S; seq_info(seq, seqbase, S);
      const int kvh = h >> 2, NTL = S >> 6;
      const int qtoken = seqbase + qblk * 256 + wid * 32 + l32;
      bf16x8 qf[4];
#pragma unroll
      for (int ks = 0; ks < 4; ++ks) qf[ks] = *(const bf16x8*)(qb + (size_t)qtoken * 512 + h * 64 + ks * 16 + hi * 8);
      const int c = tid & 7, r0 = tid >> 3;
      const u16* kp = kb + (size_t)(seqbase + r0) * 128 + kvh * 64 + c * 8;
      const u16* vp = vt + (size_t)seqbase * 128 + (size_t)(kvh * 64 + r0) * S + c * 8;
      const unsigned woff = r0 * 128 + ((c ^ ((r0 >> 1) & 7)) << 4);
      const int sw = (l32 >> 1) & 7;
      u32x4 kr = *(const u32x4*)kp, vr = *(const u32x4*)vp;
      *(LAS u32x4*)(lds + woff) = kr; *(LAS u32x4*)(lds + 8192 + woff) = vr;
      __syncthreads();
      f32x16 o[2]; o[0] = zero16(); o[1] = zero16();
      float m = 0.f, lsum = 0.f;
      for (int kt = 0; kt < NTL; ++kt) {
        const unsigned bo = (kt & 1) * 16384;
        if (kt + 1 < NTL) { kr = *(const u32x4*)(kp + (size_t)(kt + 1) * 64 * 128); vr = *(const u32x4*)(vp + (size_t)(kt + 1) * 64); }
        f32x16 st[2];
        bf16x8 kf[8];
#pragma unroll
        for (int ks = 0; ks < 4; ++ks) {
          const unsigned co = (unsigned)(((ks * 2 + hi) ^ sw) << 4);
#pragma unroll
          for (int mt = 0; mt < 2; ++mt) kf[ks * 2 + mt] = *(const LAS bf16x8*)(lds + bo + (mt * 32 + l32) * 128 + co);
        }
        __builtin_amdgcn_sched_barrier(0);
#pragma unroll
        for (int ks = 0; ks < 4; ++ks)
#pragma unroll
          for (int mt = 0; mt < 2; ++mt) {
            if (ks == 0) st[mt] = __builtin_amdgcn_mfma_f32_32x32x16_bf16(kf[ks * 2 + mt], qf[ks], zero16(), 0, 0, 0);
            else st[mt] = __builtin_amdgcn_mfma_f32_32x32x16_bf16(kf[ks * 2 + mt], qf[ks], st[mt], 0, 0, 0);
          }
        if (att_online) {
#pragma unroll
        for (int r = 0; r < 16; ++r) { st[0][r] -= m; st[1][r] -= m; }
        float ra = __builtin_fmaxf(__builtin_fmaxf(st[0][0], st[0][1]), st[0][2]), rb = __builtin_fmaxf(__builtin_fmaxf(st[1][0], st[1][1]), st[1][2]);
#pragma unroll
        for (int r = 3; r < 15; r += 2) { ra = __builtin_fmaxf(__builtin_fmaxf(ra, st[0][r]), st[0][r + 1]); rb = __builtin_fmaxf(__builtin_fmaxf(rb, st[1][r]), st[1][r + 1]); }
        float rm = __builtin_fmaxf(__builtin_fmaxf(ra, rb), __builtin_fmaxf(st[0][15], st[1][15]));
        { const auto rr = __builtin_amdgcn_permlane32_swap(__float_as_uint(rm), __float_as_uint(rm), false, false); rm = __builtin_fmaxf(__uint_as_float(rr[0]), __uint_as_float(rr[1])); }
        if (kt == 0 || __any(rm > 8.f)) {
          const float dl = (kt == 0) ? rm : fmaxf(rm, 0.f);
          m += dl;
          const float f = __builtin_amdgcn_exp2f(-dl);
          lsum *= f;
#pragma unroll
          for (int r = 0; r < 16; ++r) { st[0][r] -= dl; st[1][r] -= dl; o[0][r] *= f; o[1][r] *= f; }
        }
        }
        f32x2 pa = {0.f, 0.f}, pb = {0.f, 0.f};
#pragma unroll
        for (int r = 0; r < 16; r += 2) { const float e0 = __builtin_amdgcn_exp2f(st[0][r]); st[0][r] = e0; const float e1 = __builtin_amdgcn_exp2f(st[1][r]); st[1][r] = e1;
          const float e2 = __builtin_amdgcn_exp2f(st[0][r + 1]); st[0][r + 1] = e2; const float e3 = __builtin_amdgcn_exp2f(st[1][r + 1]); st[1][r + 1] = e3;
          f32x2 t0 = {e0, e2}, t1 = {e1, e3}; pa += t0; pb += t1; }
        pa += pb; lsum += pa.x + pa.y;
#pragma unroll
        for (int kk = 0; kk < 4; ++kk) {
          const int mt = kk >> 1, hb = (kk & 1) * 8;
          u32x4 pw; pw.x = cvtpk(st[mt][hb + 0], st[mt][hb + 1]); pw.y = cvtpk(st[mt][hb + 2], st[mt][hb + 3]); pw.z = cvtpk(st[mt][hb + 4], st[mt][hb + 5]); pw.w = cvtpk(st[mt][hb + 6], st[mt][hb + 7]);
          const bf16x8 pf = __builtin_bit_cast(bf16x8, pw);
          const unsigned cv = (unsigned)(((kk * 2 + hi) ^ sw) << 4);
#pragma unroll
          for (int dt = 0; dt < 2; ++dt) {
            const bf16x8 vf = *(const LAS bf16x8*)(lds + bo + 8192 + (dt * 32 + l32) * 128 + cv);
            o[dt] = __builtin_amdgcn_mfma_f32_32x32x16_bf16(vf, pf, o[dt], 0, 0, 0);
          }
        }
        if (kt + 1 < NTL) { const unsigned bn = ((kt + 1) & 1) * 16384; *(LAS u32x4*)(lds + bn + woff) = kr; *(LAS u32x4*)(lds + bn + 8192 + woff) = vr; }
        __syncthreads();
      }
      lsum += __shfl_xor(lsum, 32);
      const float inv = 1.f / lsum;
      {
        LAS unsigned char* wl = lds + 65536 + wid * 4096;
#pragma unroll
        for (int dt = 0; dt < 2; ++dt)
#pragma unroll
          for (int r4 = 0; r4 < 4; ++r4) {
            const int q = (dt * 32 + 8 * r4 + 4 * hi) >> 2;
            u32x2 w; w.x = cvtpk(o[dt][r4 * 4 + 0] * inv, o[dt][r4 * 4 + 1] * inv); w.y = cvtpk(o[dt][r4 * 4 + 2] * inv, o[dt][r4 * 4 + 3] * inv);
            *(LAS u32x2*)(wl + l32 * 128 + ((q ^ (l32 & 15)) << 3)) = w;
          }
        const int cc = lane & 7, rq = lane >> 3;
        const int tok0 = seqbase + qblk * 256 + wid * 32;
#pragma unroll
        for (int rd = 0; rd < 4; ++rd) {
          const int r = rd * 8 + rq;
          u32x4 v = *(const LAS u32x4*)(wl + r * 128 + ((cc ^ ((r & 15) >> 1)) << 4));
          if (r & 1) { u32x4 t; t.x = v.z; t.y = v.w; t.z = v.x; t.w = v.y; v = t; }
          const u32x4 g = *(const u32x4*)(ga + (size_t)(tok0 + r) * 512 + h * 64 + cc * 8);
          u32x4 w;
          w.x = cvtpk(__uint_as_float(v.x << 16) * __uint_as_float(g.x << 16), __uint_as_float(v.x & 0xffff0000u) * __uint_as_float(g.x & 0xffff0000u));
          w.y = cvtpk(__uint_as_float(v.y << 16) * __uint_as_float(g.y << 16), __uint_as_float(v.y & 0xffff0000u) * __uint_as_float(g.y & 0xffff0000u));
          w.z = cvtpk(__uint_as_float(v.z << 16) * __uint_as_float(g.z << 16), __uint_as_float(v.z & 0xffff0000u) * __uint_as_float(g.z & 0xffff0000u));
          w.w = cvtpk(__uint_as_float(v.w << 16) * __uint_as_float(g.w << 16), __uint_as_float(v.w & 0xffff0000u) * __uint_as_float(g.w & 0xffff0000u));
          *(u32x4*)(yb + (size_t)(tok0 + r) * 1024 + h * 64 + cc * 8) = w;
        }
      }
    } else {
      const int v = u - 1536; int seq, sb, gp;
      if (v < 512) { seq = 8 + (v >> 8); const int rem = v & 255; sb = rem >> 1; gp = rem & 1; } else { const int w = v - 512; seq = w >> 7; const int rem = w & 127; sb = rem >> 1; gp = rem & 1; }
      int seqbase, S; seq_info(seq, seqbase, S);
      const int H = S >> 6;
      const int cch = gp * 256 + wid * 32 + l32;
      const u16* arow = y1 + (size_t)seqbase * 1024 + ((size_t)cch * H + sb) * 128 + 8 * hi;
      f32x16 acc[2]; acc[0] = zero16(); acc[1] = zero16();
#pragma unroll
      for (int ks = 0; ks < 8; ++ks) {
        const bf16x8 af = *(const bf16x8*)(arow + ks * 16);
#pragma unroll
        for (int nt = 0; nt < 2; ++nt) {
          const bf16x8 bf = *(const bf16x8*)(f2t + ((size_t)(ks * 2 + nt) * 64 + lane) * 8);
          acc[nt] = __builtin_amdgcn_mfma_f32_32x32x16_bf16(af, bf, acc[nt], 0, 0, 0);
        }
      }
      const float nrm = (S == 4096) ? (1.f / 64.f) : 0.011048543456039806f;
      {
        LAS unsigned char* wl = lds + 65536 + wid * 4096;
#pragma unroll
        for (int nt = 0; nt < 2; ++nt) {
          const int rl = nt * 32 + l32;
#pragma unroll
          for (int r4 = 0; r4 < 4; ++r4) {
            const f32x4 bias = *(const f32x4*)(p.b_f + gp * 256 + wid * 32 + 8 * r4 + 4 * hi);
            u32x2 w; w.x = cvtpk(acc[nt][r4 * 4 + 0] * nrm + bias.x, acc[nt][r4 * 4 + 1] * nrm + bias.y); w.y = cvtpk(acc[nt][r4 * 4 + 2] * nrm + bias.z, acc[nt][r4 * 4 + 3] * nrm + bias.w);
            *(LAS u32x2*)(wl + rl * 64 + ((((8 * r4 + 4 * hi) >> 2) ^ (rl & 7)) << 3)) = w;
          }
        }
        const int cc = lane & 3, rq = lane >> 2;
#pragma unroll
        for (int rd = 0; rd < 4; ++rd) {
          const int r = rd * 16 + rq;
          const int token = seqbase + r * H + sb;
          u32x4 v = *(const LAS u32x4*)(wl + r * 64 + ((cc ^ ((r & 7) >> 1)) << 4));
          if (r & 1) { u32x4 t; t.x = v.z; t.y = v.w; t.z = v.x; t.w = v.y; v = t; }
          const int ch = gp * 256 + wid * 32 + cc * 8;
          const u32x4 g = *(const u32x4*)(gf + (size_t)token * 512 + ch);
          u32x4 w;
          w.x = cvtpk(__uint_as_float(v.x << 16) * __uint_as_float(g.x << 16), __uint_as_float(v.x & 0xffff0000u) * __uint_as_float(g.x & 0xffff0000u));
          w.y = cvtpk(__uint_as_float(v.y << 16) * __uint_as_float(g.y << 16), __uint_as_float(v.y & 0xffff0000u) * __uint_as_float(g.y & 0xffff0000u));
          w.z = cvtpk(__uint_as_float(v.z << 16) * __uint_as_float(g.z << 16), __uint_as_float(v.z & 0xffff0000u) * __uint_as_float(g.z & 0xffff0000u));
          w.w = cvtpk(__uint_as_float(v.w << 16) * __uint_as_float(g.w << 16), __uint_as_float(v.w & 0xffff0000u) * __uint_as_float(g.w & 0xffff0000u));
          *(u32x4*)(yb + (size_t)token * 1024 + 512 + ch) = w;
        }
      }
    }
  }
  xcd_barrier(gbar);

  {
    const int wy = wid >> 2, wx = wid & 3;
    for (int u = vb; u < 192 * 4; u += G) {
      const int mt = u >> 2, nt = u & 3;
      f32x16 acc[4][2];
#pragma unroll
      for (int a = 0; a < 4; ++a)
#pragma unroll
        for (int b = 0; b < 2; ++b) acc[a][b] = zero16();
      gemm_mainloop(lds, wot + (size_t)nt * 256 * DM, yb + (size_t)mt * 256 * DM, acc, tid);
#pragma unroll
      for (int ni = 0; ni < 2; ++ni) {
        const int token = mt * 256 + wx * 64 + ni * 32 + l32;
        u16* yrow = yw + (size_t)token * DM;
#pragma unroll
        for (int mi = 0; mi < 4; ++mi)
#pragma unroll
          for (int r4 = 0; r4 < 4; ++r4) {
            const int col = nt * 256 + wy * 128 + mi * 32 + 8 * r4 + 4 * hi;
            u32x2 w; w.x = cvtpk(acc[mi][ni][r4 * 4 + 0], acc[mi][ni][r4 * 4 + 1]); w.y = cvtpk(acc[mi][ni][r4 * 4 + 2], acc[mi][ni][r4 * 4 + 3]);
            stage_put(lds, wx * 64 + ni * 32 + l32, wy * 128 + mi * 32 + 8 * r4 + 4 * hi, w);
          }
      }
      stage_flush(lds, yw + (size_t)mt * 256 * DM + nt * 256, DM, wid, lane);
    }
  }
  xcd_barrier(gbar);

  for (int row = gw; row < NTOK; row += NW) {
    const float* xr = (row < NPROMPT) ? p.x_prompt + (size_t)row * DM : p.x_sample + (size_t)(row - NPROMPT) * DM;
    const u32x2* yr = (const u32x2*)(yw + (size_t)row * DM);
    f32x4 v[4]; float ss = 0.f;
#pragma unroll
    for (int j = 0; j < 4; ++j) {
      const f32x4 xv = __builtin_nontemporal_load((const f32x4*)xr + lane + 64 * j); const u32x2 y = yr[lane + 64 * j];
      v[j].x = xv.x + __uint_as_float(y.x << 16); v[j].y = xv.y + __uint_as_float(y.x & 0xffff0000u); v[j].z = xv.z + __uint_as_float(y.y << 16); v[j].w = xv.w + __uint_as_float(y.y & 0xffff0000u);
      ss += v[j].x * v[j].x + v[j].y * v[j].y + v[j].z * v[j].z + v[j].w * v[j].w;
    }
#pragma unroll
    for (int o = 1; o < 64; o <<= 1) ss += __shfl_xor(ss, o);
    const float rn = rsqrtf(ss * (1.f / DM) + EPS);
    f32x4* orow = (f32x4*)(p.out + (size_t)row * DM);
#pragma unroll
    for (int j = 0; j < 4; ++j) {
      const f32x4 w = ((const f32x4*)p.final_norm)[lane + 64 * j]; f32x4 z = v[j];
      z.x *= rn * w.x; z.y *= rn * w.y; z.z *= rn * w.z; z.w *= rn * w.w; orow[lane + 64 * j] = z;
    }
  }
}

extern "C" void kernel_launch(void* const* d_in, const int* in_sizes, int n_in, void* d_out, int out_size, void* d_ws, size_t ws_size, hipStream_t stream) {
  static int grid_blocks = 0;
  if (!grid_blocks) {
    int dev = 0, cus = 0, per_cu = 0;
    hipGetDevice(&dev);
    hipDeviceGetAttribute(&cus, hipDeviceAttributeMultiprocessorCount, dev);
    hipFuncSetAttribute((const void*)fwd_kernel, hipFuncAttributeMaxDynamicSharedMemorySize, LDS_BYTES);
    hipOccupancyMaxActiveBlocksPerMultiprocessor(&per_cu, (const void*)fwd_kernel, NTHR, LDS_BYTES);
    if (per_cu < 1) per_cu = 1;
    if (per_cu > 1) per_cu = 1;
    grid_blocks = cus * per_cu;
  }
  hipMemsetAsync((char*)d_ws + OFF_BAR, 0, 16384, stream);
  Params p{};
  p.x_prompt = (const float*)d_in[0]; p.x_sample = (const float*)d_in[1]; p.ln_w = (const float*)d_in[2]; p.w_in = (const float*)d_in[3];
  p.q_norm = (const float*)d_in[4]; p.k_norm = (const float*)d_in[5]; p.w_f = (const float*)d_in[6]; p.b_f = (const float*)d_in[7];
  p.w_out = (const float*)d_in[8]; p.final_norm = (const float*)d_in[9];
  p.out = (float*)d_out; p.ws = (unsigned char*)d_ws;
  void* args[] = {&p};
  hipError_t e = hipLaunchCooperativeKernel((const void*)fwd_kernel, dim3(grid_blocks), dim3(NTHR), args, LDS_BYTES, stream);
  if (e != hipSuccess) fprintf(stderr, "cooperative launch failed: %s (grid %d)\n", hipGetErrorString(e), grid_blocks);
}
```

```cpp
#include <hip/hip_runtime.h>
#include <hip/hip_cooperative_groups.h>
#include <cstdio>
#include <cstdint>
namespace cg = cooperative_groups;

typedef unsigned short u16;
typedef short bf16x8 __attribute__((ext_vector_type(8)));
typedef float f32x16 __attribute__((ext_vector_type(16)));
typedef float f32x4 __attribute__((ext_vector_type(4)));
typedef float f32x2 __attribute__((ext_vector_type(2)));
typedef unsigned u32x4 __attribute__((ext_vector_type(4)));
typedef unsigned u32x2 __attribute__((ext_vector_type(2)));
typedef __bf16 bf16x2_t __attribute__((ext_vector_type(2)));
#define LAS __attribute__((address_space(3)))

constexpr int DM = 1024, NTOK = 49152, NPROMPT = 32768, N1 = 2816, WIN_LD = 2304;
constexpr float EPS = 1e-6f;
constexpr float QSCALE = 0.125f * 1.4426950408889634f;
constexpr size_t MiB = 1u << 20, KiB = 1u << 10;
constexpr size_t OFF_XB = 0;
constexpr size_t OFF_RINV = 96 * MiB;
constexpr size_t OFF_ROWSS = 96 * MiB + 256 * KiB;
constexpr size_t OFF_ROPE = 96 * MiB + 512 * KiB;
constexpr size_t OFF_TW = 96 * MiB + 576 * KiB;
constexpr size_t OFF_F1A = 96 * MiB + 640 * KiB;
constexpr size_t OFF_F1B = 96 * MiB + 704 * KiB;
constexpr size_t OFF_F2 = 96 * MiB + 768 * KiB;
constexpr size_t OFF_MF = 97 * MiB;
constexpr size_t OFF_W1T = 98 * MiB;
constexpr size_t OFF_WOT = 104 * MiB;
constexpr size_t OFF_Q = 112 * MiB;
constexpr size_t OFF_K = 160 * MiB;
constexpr size_t OFF_VT = 172 * MiB;
constexpr size_t OFF_GA = 184 * MiB;
constexpr size_t OFF_GF = 232 * MiB;
constexpr size_t OFF_YB = 280 * MiB;
constexpr size_t OFF_BAR = 96 * MiB + 832 * KiB;
constexpr int LDS_MAIN = 131072, LDS_BYTES = LDS_MAIN + 64;
constexpr int NTHR = 512, NWAVE = 8;

struct Params {
  const float *x_prompt, *x_sample, *ln_w, *w_in, *q_norm, *k_norm, *w_f, *b_f, *w_out, *final_norm;
  float* out; unsigned char* ws;
};

__device__ __forceinline__ unsigned cvtpk(float lo, float hi) { f32x2 v = {lo, hi}; bf16x2_t b = __builtin_convertvector(v, bf16x2_t); return __builtin_bit_cast(unsigned, b); }
__device__ __forceinline__ float bf2f(unsigned short h) { return __uint_as_float(((unsigned)h) << 16); }
__device__ __forceinline__ float silu(float v) { return v * __builtin_amdgcn_rcpf(1.f + __builtin_amdgcn_exp2f(-1.4426950408889634f * v)); }
__device__ __forceinline__ void seq_info(int seq, int& seqbase, int& S) { if (seq < 8) { seqbase = seq * 4096; S = 4096; } else { seqbase = NPROMPT + (seq - 8) * 8192; S = 8192; } }
__device__ __forceinline__ void seq_of_row(int row, int& seqbase, int& S) { if (row < NPROMPT) { seqbase = row & ~4095; S = 4096; } else { seqbase = NPROMPT + ((row - NPROMPT) & ~8191); S = 8192; } }
__device__ __forceinline__ f32x16 zero16() { f32x16 z; for (int i = 0; i < 16; ++i) z[i] = 0.f; return z; }


#define XB_TMO      128
#define XB_XCNT(j)  (256  + 64 * (j))
#define XB_XSUB(j)  (1280 + 64 * (j))
#define XB_XGEN(j)  (2304 + 64 * (j))
#define XB_TOP      3328
#define XB_TOPGEN   3392
#define XCD_BAR_WORDS 3456
#define XB_SPIN_CAP (1u << 18)
__device__ __forceinline__ unsigned xb_ld(unsigned* p)              { return __hip_atomic_load(p, __ATOMIC_RELAXED, __HIP_MEMORY_SCOPE_AGENT); }
__device__ __forceinline__ unsigned xb_add(unsigned* p, unsigned v) { return __hip_atomic_fetch_add(p, v, __ATOMIC_RELAXED, __HIP_MEMORY_SCOPE_AGENT); }
__device__ __forceinline__ unsigned xb_xcc_id() { return (unsigned)__builtin_amdgcn_s_getreg((3 << 11) | 20) & 0xFu; }
#define XB_SPIN(cond, bar) do { unsigned _sp = 0; while (cond) { __builtin_amdgcn_s_sleep(1); \
    if ((++_sp & 255u) == 0u) { if (xb_ld(&(bar)[XB_TMO])) break; if (_sp > XB_SPIN_CAP) { atomicAdd(&(bar)[XB_TMO], 1u); break; } } } } while (0)
struct XcdBarrier { unsigned* bar; unsigned x; volatile LAS unsigned* st; };
__device__ __forceinline__ XcdBarrier xcd_barrier_post(unsigned* bar, volatile LAS unsigned* st) {
  XcdBarrier b; b.bar = bar; b.x = xb_xcc_id(); b.st = st;
  if (threadIdx.x == 0) (void)xb_add(&bar[XB_XCNT(b.x)], 1u);
  return b;
}
__device__ __forceinline__ void xcd_barrier_complete(unsigned* bar, unsigned x, unsigned& nloc, unsigned& nx) {
  const unsigned G = gridDim.x * gridDim.y * gridDim.z;
  unsigned sum, cnt, mine, sp = 0u;
  for (;;) {
    sum = 0u; cnt = 0u; mine = 0u;
#pragma unroll
    for (unsigned j = 0; j < 16; ++j) { const unsigned c = xb_ld(&bar[XB_XCNT(j)]); sum += c; cnt += (c > 0u) ? 1u : 0u; mine = (j == x) ? c : mine; }
    if (sum == G) break;
    __builtin_amdgcn_s_sleep(1);
    if ((++sp & 255u) == 0u) { if (xb_ld(&bar[XB_TMO])) break; if (sp > XB_SPIN_CAP) { atomicAdd(&bar[XB_TMO], 1u); break; } }
  }
  nloc = mine > 0u ? mine : 1u; nx = cnt > 0u ? cnt : 1u;
}
__device__ __forceinline__ void xcd_barrier(const XcdBarrier& b) {
  asm volatile("s_waitcnt vmcnt(0)" ::: "memory");
  __syncthreads();
  if (threadIdx.x == 0) {
    unsigned* bar = b.bar;
    __builtin_amdgcn_s_waitcnt(0);
    unsigned nloc = b.st[0], nx = b.st[1];
    if (nloc == 0u) { xcd_barrier_complete(bar, b.x, nloc, nx); b.st[0] = nloc; b.st[1] = nx; }
    const unsigned old = xb_add(&bar[XB_XSUB(b.x)], 1u);
    const unsigned gen = old / nloc;
    if (old + 1u == (gen + 1u) * nloc) {
      __builtin_amdgcn_fence(__ATOMIC_RELEASE, "agent");
      asm volatile("s_waitcnt vmcnt(0)" ::: "memory");
      const unsigned og = xb_add(&bar[XB_TOP], 1u);
      const unsigned tg = og / nx;
      if (og + 1u == (tg + 1u) * nx) xb_add(&bar[XB_TOPGEN], 1u);
      else XB_SPIN(xb_ld(&bar[XB_TOPGEN]) == tg, bar);
      __builtin_amdgcn_fence(__ATOMIC_ACQUIRE, "agent");
      xb_add(&bar[XB_XGEN(b.x)], 1u);
      asm volatile("s_waitcnt vmcnt(0)" ::: "memory");
    } else {
      XB_SPIN(xb_ld(&bar[XB_XGEN(b.x)]) == gen, bar);
      __builtin_amdgcn_fence(__ATOMIC_ACQUIRE, "agent");
      asm volatile("s_waitcnt vmcnt(0)" ::: "memory");
    }
  }
  __syncthreads();
}

__device__ __forceinline__ void gemm_mainloop(LAS unsigned char* lds, const u16* Xg, const u16* Yg, f32x16 (&acc)[4][2], int tid) {
  const int lane = tid & 63, wid = __builtin_amdgcn_readfirstlane(tid >> 6), wy = wid >> 2, wx = wid & 3, l32 = lane & 31, hi = lane >> 5;
  const int drow = wid * 16 + (lane >> 2), dch = (lane & 3) ^ ((drow >> 2) & 3);
  const u16* xp = Xg + (size_t)drow * 1024 + dch * 8;
  const u16* yp = Yg + (size_t)drow * 1024 + dch * 8;
  const int sw = (l32 >> 2) & 3;
  const unsigned xbase = (wy * 128 + l32) * 64, ybase = 16384 + (wx * 64 + l32) * 64;
  const unsigned ldsw = (unsigned)wid * 1024u;
#define GEMM_DMA(j_) do { const unsigned so_ = (unsigned)(((j_) & 3) * 32768); _Pragma("unroll") for (int i_ = 0; i_ < 2; ++i_) { \
    __builtin_amdgcn_global_load_lds((const unsigned*)(xp + (size_t)i_ * 128 * 1024 + (j_) * 32), (LAS unsigned*)(lds + so_ + ldsw + i_ * 8192), 16, 0, 0); \
    __builtin_amdgcn_global_load_lds((const unsigned*)(yp + (size_t)i_ * 128 * 1024 + (j_) * 32), (LAS unsigned*)(lds + so_ + 16384 + ldsw + i_ * 8192), 16, 0, 0); } } while (0)
  GEMM_DMA(0); GEMM_DMA(1); GEMM_DMA(2);
#pragma unroll 4
  for (int j = 0; j < 32; ++j) {
    const unsigned bo = (unsigned)((j & 3) * 32768);
    if (j < 30) asm volatile("s_waitcnt vmcnt(8) lgkmcnt(0)" ::: "memory");
    else if (j == 30) asm volatile("s_waitcnt vmcnt(4) lgkmcnt(0)" ::: "memory");
    else asm volatile("s_waitcnt vmcnt(0) lgkmcnt(0)" ::: "memory");
    __builtin_amdgcn_s_barrier();
    asm volatile("" ::: "memory");
    if (j + 3 < 32) GEMM_DMA(j + 3);
#pragma unroll
    for (int ks = 0; ks < 2; ++ks) {
      const unsigned co = (unsigned)(((ks * 2 + hi) ^ sw) << 4);
      bf16x8 xf[4], yf[2];
#pragma unroll
      for (int ni = 0; ni < 2; ++ni) yf[ni] = *(const LAS bf16x8*)(lds + bo + ybase + ni * 2048 + co);
#pragma unroll
      for (int mi = 0; mi < 4; ++mi) xf[mi] = *(const LAS bf16x8*)(lds + bo + xbase + mi * 2048 + co);
#pragma unroll
      for (int mi = 0; mi < 4; ++mi)
#pragma unroll
        for (int ni = 0; ni < 2; ++ni) acc[mi][ni] = __builtin_amdgcn_mfma_f32_32x32x16_bf16(xf[mi], yf[ni], acc[mi][ni], 0, 0, 0);
    }
  }
#undef GEMM_DMA
  asm volatile("s_waitcnt lgkmcnt(0)" ::: "memory");
  __builtin_amdgcn_s_barrier();
  asm volatile("" ::: "memory");
}


__device__ __forceinline__ void stage_put(LAS unsigned char* lds, int row, int col, u32x2 w) { *(LAS u32x2*)(lds + row * 512 + (((col >> 2) ^ (row & 63)) << 3)) = w; }
__device__ __forceinline__ void stage_flush(LAS unsigned char* lds, u16* dst, int ld, int wid, int lane) {
  __syncthreads();
  const int c = lane & 31, hh = lane >> 5;
#pragma unroll 2
  for (int rd = 0; rd < 16; ++rd) {
    const int r = rd * 16 + wid * 2 + hh;
    u32x4 v = *(const LAS u32x4*)(lds + r * 512 + ((c ^ ((r & 63) >> 1)) << 4));
    if (r & 1) { u32x4 t; t.x = v.z; t.y = v.w; t.z = v.x; t.w = v.y; v = t; }
    __builtin_nontemporal_store(v, (u32x4*)(dst + (size_t)r * ld + c * 8));
  }
  __syncthreads();
}

__global__ void __launch_bounds__(512, 2) fwd_kernel(Params p) {
  extern __shared__ __attribute__((aligned(16))) unsigned char smem[];
  LAS unsigned char* lds = (LAS unsigned char*)smem;
  cg::grid_group grid = cg::this_grid();
  if (p.ws == nullptr) grid.sync();
  volatile LAS unsigned* misc = (volatile LAS unsigned*)(lds + LDS_MAIN);
  if (threadIdx.x < 16) misc[threadIdx.x] = 0u;
  __syncthreads();
  const XcdBarrier gbar = xcd_barrier_post((unsigned*)(p.ws + OFF_BAR), misc);
  const int tid = threadIdx.x, lane = tid & 63, wid = __builtin_amdgcn_readfirstlane(tid >> 6), l32 = lane & 31, hi = lane >> 5;
  const int G = gridDim.x;
  const int vb = (G % 8 == 0) ? (int)((blockIdx.x % 8) * (G / 8) + blockIdx.x / 8) : (int)blockIdx.x;
  unsigned char* ws = p.ws;
  u16* xb = (u16*)(ws + OFF_XB); u16* y1 = (u16*)(ws + OFF_XB);
  float* rinv = (float*)(ws + OFF_RINV); float* rowss = (float*)(ws + OFF_ROWSS);
  float* rope = (float*)(ws + OFF_ROPE); float* tw = (float*)(ws + OFF_TW);
  u16* f1a = (u16*)(ws + OFF_F1A); u16* f1b = (u16*)(ws + OFF_F1B); u16* f2t = (u16*)(ws + OFF_F2);
  float* mf = (float*)(ws + OFF_MF);
  u16* w1t = (u16*)(ws + OFF_W1T); u16* wot = (u16*)(ws + OFF_WOT);
  u16* qb = (u16*)(ws + OFF_Q); u16* kb = (u16*)(ws + OFF_K); u16* vt = (u16*)(ws + OFF_VT);
  u16* ga = (u16*)(ws + OFF_GA); u16* gf = (u16*)(ws + OFF_GF); u16* yb = (u16*)(ws + OFF_YB);
  u16* yw = (u16*)(ws + OFF_GA);
  u16* zt = (u16*)p.out;
  unsigned* pcnt = (unsigned*)(ws + OFF_BAR) + 3584;
  const int gtid = blockIdx.x * NTHR + tid, NT_ = G * NTHR;
  const int gw = blockIdx.x * NWAVE + wid, NW = G * NWAVE;

  for (int row = gw; row < NTOK; row += NW) {
    const float* xr = (row < NPROMPT) ? p.x_prompt + (size_t)row * DM : p.x_sample + (size_t)(row - NPROMPT) * DM;
    f32x4 v[4]; float ss = 0.f;
#pragma unroll
    for (int j = 0; j < 4; ++j) { v[j] = __builtin_nontemporal_load((const f32x4*)xr + lane + 64 * j); ss += v[j].x * v[j].x + v[j].y * v[j].y + v[j].z * v[j].z + v[j].w * v[j].w; }
#pragma unroll
    for (int o = 1; o < 64; o <<= 1) ss += __shfl_xor(ss, o);
    u32x2* o8 = (u32x2*)(xb + (size_t)row * DM);
#pragma unroll
    for (int j = 0; j < 4; ++j) { u32x2 w; w.x = cvtpk(v[j].x, v[j].y); w.y = cvtpk(v[j].z, v[j].w); o8[lane + 64 * j] = w; }
    if (lane == 0) rinv[row] = rsqrtf(ss * (1.f / DM) + EPS);
  }
  for (int i = gtid; i < 192 * 16; i += NT_) {
    const int pr = i >> 4, j = i & 15; const float pos = (float)(pr < 128 ? pr : pr - 128);
    const float invf = powf(10000.f, -(float)j / 16.f); float s, c; sincosf(pos * invf, &s, &c);
    rope[2 * i] = c; rope[2 * i + 1] = s;
  }
  for (int i = gtid; i < 8192; i += NT_) { float s, c; sincospif((float)i / 4096.f, &s, &c); tw[2 * i] = c; tw[2 * i + 1] = s; }
  for (int i = gtid; i < 8192 + 32768 + 8192; i += NT_) {
    float val; u16* dst;
    if (i < 8192 + 32768) {
      const bool big = i >= 8192; const int e = big ? i - 8192 : i; const int H = big ? 128 : 64, KS = big ? 8 : 4;
      const int j = e & 7, ln = (e >> 3) & 63, cs = (e >> 9) & 1, nt = (e >> 10) & 1, rest = e >> 11; const int ks = rest % KS, nb = rest / KS;
      const int sb = nb * 64 + nt * 32 + (ln & 31), th = ks * 16 + 8 * (j >> 2) + 4 * (ln >> 5) + (j & 3);
      float s, c; sincospif((float)((sb * th) & (H - 1)) * (2.f / (float)H), &s, &c); val = cs ? s : c; dst = (big ? f1b : f1a) + e;
    } else {
      const int e = i - 8192 - 32768; const int j = e & 7, ln = (e >> 3) & 63, nt = (e >> 9) & 1, ks = e >> 10;
      const int sa = nt * 32 + (ln & 31), kidx = ks * 16 + 8 * (ln >> 5) + j, part = kidx >> 6, tl = kidx & 63;
      float s, c; sincospif((float)((sa * tl) & 63) * (1.f / 32.f), &s, &c); val = part ? s : c; dst = f2t + e;
    }
    *dst = (u16)(cvtpk(val, 0.f) & 0xffffu);
  }
  for (int i = gtid; i < 128 * 1792; i += NT_) {
    const int k8 = i / 1792, jn = i % 1792; const int n = jn < 1280 ? jn : jn + 1024, src = jn < 1280 ? jn : jn + 512;
    float v[8];
#pragma unroll
    for (int e = 0; e < 8; ++e) v[e] = p.ln_w[k8 * 8 + e] * p.w_in[(size_t)(k8 * 8 + e) * WIN_LD + src];
    u32x4 w; w.x = cvtpk(v[0], v[1]); w.y = cvtpk(v[2], v[3]); w.z = cvtpk(v[4], v[5]); w.w = cvtpk(v[6], v[7]);
    *(u32x4*)(w1t + (size_t)n * DM + k8 * 8) = w;
  }
  for (int i = gtid; i < 128 * 1024; i += NT_) {
    const int k8 = i >> 10, n = i & 1023; float v[8];
#pragma unroll
    for (int e = 0; e < 8; ++e) v[e] = p.w_out[(size_t)(k8 * 8 + e) * DM + n];
    u32x4 w; w.x = cvtpk(v[0], v[1]); w.y = cvtpk(v[2], v[3]); w.z = cvtpk(v[4], v[5]); w.w = cvtpk(v[6], v[7]);
    *(u32x4*)(wot + (size_t)n * DM + k8 * 8) = w;
  }
  for (int i = gtid; i < 4 * 128 * 128; i += NT_) {
    const int c = i & 127, cp = (i >> 7) & 127, g = i >> 14; float a1 = 0.f, a2 = 0.f;
    for (int j = 0; j < 128; ++j) { float s, cc; sincospif((float)((cp * j) & 127) * (1.f / 64.f), &s, &cc); const float w = p.w_f[(size_t)(g * 128 + j) * 128 + c]; a1 += cc * w; a2 += s * w; }
    mf[i] = a1 * 0.08838834764831845f; mf[65536 + i] = -a2 * 0.08838834764831845f;
  }
  xcd_barrier(gbar);

  for (int u = blockIdx.x; u < 128; u += G) {
    const int g = u >> 5, d0 = (u & 31) * 32;
    LAS float* wt = (LAS float*)lds;
#pragma unroll
    for (int i = 0; i < 8; ++i) { const int idx = tid + NTHR * i, dd = idx >> 7, cc = idx & 127; wt[cc * 32 + dd] = p.w_in[(size_t)(d0 + dd) * WIN_LD + 1280 + g * 128 + cc] * p.ln_w[d0 + dd]; }
    __syncthreads();
    const int c = tid & 127, q4 = tid >> 7;
    float a1[8], a2[8];
#pragma unroll
    for (int e = 0; e < 8; ++e) { a1[e] = 0.f; a2[e] = 0.f; }
    for (int cp = 0; cp < 128; ++cp) {
      const float m1 = mf[(g * 128 + cp) * 128 + c], m2 = mf[65536 + (g * 128 + cp) * 128 + c];
      const f32x4 w0 = *(const LAS f32x4*)(wt + cp * 32 + q4 * 8), w1 = *(const LAS f32x4*)(wt + cp * 32 + q4 * 8 + 4);
      a1[0] += w0.x * m1; a1[1] += w0.y * m1; a1[2] += w0.z * m1; a1[3] += w0.w * m1; a1[4] += w1.x * m1; a1[5] += w1.y * m1; a1[6] += w1.z * m1; a1[7] += w1.w * m1;
      a2[0] += w0.x * m2; a2[1] += w0.y * m2; a2[2] += w0.z * m2; a2[3] += w0.w * m2; a2[4] += w1.x * m2; a2[5] += w1.y * m2; a2[6] += w1.z * m2; a2[7] += w1.w * m2;
    }
    u32x4 w; w.x = cvtpk(a1[0], a1[1]); w.y = cvtpk(a1[2], a1[3]); w.z = cvtpk(a1[4], a1[5]); w.w = cvtpk(a1[6], a1[7]);
    *(u32x4*)(w1t + (size_t)(1280 + g * 128 + c) * DM + d0 + q4 * 8) = w;
    w.x = cvtpk(a2[0], a2[1]); w.y = cvtpk(a2[2], a2[3]); w.z = cvtpk(a2[4], a2[5]); w.w = cvtpk(a2[6], a2[7]);
    *(u32x4*)(w1t + (size_t)(1792 + g * 128 + c) * DM + d0 + q4 * 8) = w;
    __syncthreads();
  }
  xcd_barrier(gbar);

  {
    const int wy = wid >> 2, wx = wid & 3;
    for (int u = vb; u < 192 * 11; u += G) {
      const int mt = u / 11, nt = u % 11;
      const bool swapped = !(nt >= 5 && nt < 9);
      const u16* At = xb + (size_t)mt * 256 * DM; const u16* Wt = w1t + (size_t)nt * 256 * DM;
      f32x16 acc[4][2];
#pragma unroll
      for (int a = 0; a < 4; ++a)
#pragma unroll
        for (int b = 0; b < 2; ++b) acc[a][b] = zero16();
      gemm_mainloop(lds, swapped ? Wt : At, swapped ? At : Wt, acc, tid);
      const int rowbase = mt * 256;
      int seqbase, S; seq_of_row(rowbase, seqbase, S);
      if (swapped) {
        if (nt < 2 || (nt == 2 && wy == 0)) {
          const bool isq = nt < 2;
          const float* nw = isq ? p.q_norm : p.k_norm;
          const float osc = isq ? QSCALE : 1.f;
#pragma unroll
          for (int ni = 0; ni < 2; ++ni) {
            const int token = rowbase + wx * 64 + ni * 32 + l32, pos = token - seqbase;
            const float ri = rinv[token];
#pragma unroll
            for (int hp = 0; hp < 2; ++hp) {
              float ss = 0.f;
#pragma unroll
              for (int mm = 0; mm < 2; ++mm)
#pragma unroll
                for (int r = 0; r < 16; ++r) { const float v = acc[hp * 2 + mm][ni][r] * ri; acc[hp * 2 + mm][ni][r] = v; ss += v * v; }
              ss += __shfl_xor(ss, 32);
              const float rn = rsqrtf(ss * (1.f / 64.f) + EPS);
              const int head = isq ? (nt * 4 + wy * 2 + hp) : hp;
#pragma unroll
              for (int mm = 0; mm < 2; ++mm) {
                const float posv = (float)((mm == 0) ? (pos >> 6) : (pos & 63));
#pragma unroll
                for (int r4 = 0; r4 < 4; ++r4) {
                  const int d = mm * 32 + 8 * r4 + 4 * hi;
                  const f32x4 wv = *(const f32x4*)(nw + d);
                  f32x4 cs;
                  { float pv2 = posv; asm volatile("" : "+v"(pv2));
                    const float jf = (float)(4 * r4 + 2 * hi);
                    const float rv0 = pv2 * (__builtin_amdgcn_exp2f(-0.8304820237218406f * jf) * 0.15915494309189535f), rv1 = pv2 * (__builtin_amdgcn_exp2f(-0.8304820237218406f * (jf + 1.f)) * 0.15915494309189535f);
                    cs.x = __builtin_amdgcn_cosf(rv0); cs.y = __builtin_amdgcn_sinf(rv0); cs.z = __builtin_amdgcn_cosf(rv1); cs.w = __builtin_amdgcn_sinf(rv1); }
                  const float x0 = acc[hp * 2 + mm][ni][r4 * 4 + 0] * rn * wv.x, x1 = acc[hp * 2 + mm][ni][r4 * 4 + 1] * rn * wv.y;
                  const float x2 = acc[hp * 2 + mm][ni][r4 * 4 + 2] * rn * wv.z, x3 = acc[hp * 2 + mm][ni][r4 * 4 + 3] * rn * wv.w;
                  const float o0 = (x0 * cs.x - x1 * cs.y) * osc, o1 = (x0 * cs.y + x1 * cs.x) * osc;
                  const float o2 = (x2 * cs.z - x3 * cs.w) * osc, o3 = (x2 * cs.w + x3 * cs.z) * osc;
                  u32x2 w; w.x = cvtpk(o0, o1); w.y = cvtpk(o2, o3);
                  if (isq) *(u32x2*)(qb + (size_t)token * 512 + head * 64 + d) = w;
                  else *(u32x2*)(kb + (size_t)token * 128 + head * 64 + d) = w;
                }
              }
            }
          }
        } else if (nt == 2) {
          u16* dst = vt + (size_t)seqbase * 128;
#pragma unroll
          for (int ni = 0; ni < 2; ++ni) {
            const int token = rowbase + wx * 64 + ni * 32 + l32, pos0 = token - seqbase;
            const int pos = (pos0 & ~12) | ((pos0 & 4) << 1) | ((pos0 & 8) >> 1);
            const float ri = rinv[token];
            u16* pv = dst + (size_t)(4 * hi) * S + pos;
#pragma unroll
            for (int mi = 0; mi < 4; ++mi)
#pragma unroll
              for (int r4 = 0; r4 < 4; ++r4) {
#pragma unroll
                for (int e = 0; e < 4; ++e) { *pv = (u16)(cvtpk(acc[mi][ni][r4 * 4 + e] * ri, 0.f) & 0xffffu); pv += S; asm volatile("" : "+v"(pv)); }
                pv += 4 * S; asm volatile("" : "+v"(pv));
              }
          }
        } else {
          u16* gdst = (nt < 5) ? ga : gf; const int cb = ((nt < 5) ? (nt - 3) : (nt - 9)) * 256 + wy * 128;
#pragma unroll
          for (int ni = 0; ni < 2; ++ni) {
            const int token = rowbase + wx * 64 + ni * 32 + l32; const float ri = rinv[token];
#pragma unroll
            for (int mi = 0; mi < 4; ++mi)
#pragma unroll
              for (int r4 = 0; r4 < 4; ++r4) {
                const float v0 = silu(acc[mi][ni][r4 * 4 + 0] * ri), v1 = silu(acc[mi][ni][r4 * 4 + 1] * ri), v2 = silu(acc[mi][ni][r4 * 4 + 2] * ri), v3 = silu(acc[mi][ni][r4 * 4 + 3] * ri);
                u32x2 w; w.x = cvtpk(v0, v1); w.y = cvtpk(v2, v3);
                stage_put(lds, wx * 64 + ni * 32 + l32, wy * 128 + mi * 32 + 8 * r4 + 4 * hi, w);
              }
          }
          stage_flush(lds, gdst + (size_t)rowbase * 512 + (cb - wy * 128), 512, wid, lane);
        }
      } else {
        u16* dst = zt + (size_t)seqbase * 1024 + (size_t)(nt - 5) * 256 * S;
#pragma unroll
        for (int mi = 0; mi < 4; ++mi)
#pragma unroll
          for (int r4 = 0; r4 < 4; ++r4) {
            const int token = rowbase + wy * 128 + mi * 32 + 8 * r4 + 4 * hi;
            const f32x4 ri = *(const f32x4*)(rinv + token);
#pragma unroll
            for (int ni = 0; ni < 2; ++ni) {
              const int ch = wx * 64 + ni * 32 + l32;
              u32x2 w; w.x = cvtpk(acc[mi][ni][r4 * 4 + 0] * ri.x, acc[mi][ni][r4 * 4 + 1] * ri.y); w.y = cvtpk(acc[mi][ni][r4 * 4 + 2] * ri.z, acc[mi][ni][r4 * 4 + 3] * ri.w);
              stage_put(lds, ch, wy * 128 + mi * 32 + 8 * r4 + 4 * hi, w);
            }
          }
        stage_flush(lds, dst + (rowbase - seqbase), S, wid, lane);
      }
    }
  }
  xcd_barrier(gbar);

  for (int u = gw; u < 6144; u += NW) {
    int seq, c, nb;
    if (u < 2048) { seq = 8 + (u >> 10); c = (u & 1023) >> 1; nb = u & 1; } else { const int v = u - 2048; seq = v >> 9; c = v & 511; nb = 0; }
    int seqbase, S; seq_info(seq, seqbase, S);
    const int KS = S >> 10;
    const u16* ftab = (S == 4096) ? f1a : f1b;
    const u16* zre = zt + (size_t)seqbase * 1024 + (size_t)c * S;
    const u16* zim = zre + (size_t)512 * S;
    f32x16 yr[2][2], yi[2][2];
#pragma unroll
    for (int a = 0; a < 2; ++a)
#pragma unroll
      for (int b = 0; b < 2; ++b) { yr[a][b] = zero16(); yi[a][b] = zero16(); }
    bf16x8 idf[2];
#pragma unroll
    for (int h2 = 0; h2 < 2; ++h2) { u32x4 t;
      const int b = l32 - 16 * h2 - 8 * hi;
      t.x = (b == 0 ? 0x3f80u : 0u) | (b == 1 ? 0x3f800000u : 0u); t.y = (b == 2 ? 0x3f80u : 0u) | (b == 3 ? 0x3f800000u : 0u);
      t.z = (b == 4 ? 0x3f80u : 0u) | (b == 5 ? 0x3f800000u : 0u); t.w = (b == 6 ? 0x3f80u : 0u) | (b == 7 ? 0x3f800000u : 0u);
      idf[h2] = __builtin_bit_cast(bf16x8, t); }
    for (int mt = 0; mt < (KS >> 1); ++mt) {
      bf16x8 zr[2][2], zi[2][2];
      {
        const u16* pr = zre + (size_t)(mt * 32 + l32) * 64 + 8 * hi;
        const u16* pi = zim + (size_t)(mt * 32 + l32) * 64 + 8 * hi;
        bf16x8 ar[4], ai[4];
#pragma unroll
        for (int kk = 0; kk < 4; ++kk) { ar[kk] = *(const bf16x8*)(pr + kk * 16); ai[kk] = *(const bf16x8*)(pi + kk * 16); }
#pragma unroll
        for (int nt = 0; nt < 2; ++nt) {
          f32x16 dr = __builtin_amdgcn_mfma_f32_32x32x16_bf16(ar[2 * nt], idf[0], zero16(), 0, 0, 0);
          dr = __builtin_amdgcn_mfma_f32_32x32x16_bf16(ar[2 * nt + 1], idf[1], dr, 0, 0, 0);
          f32x16 di = __builtin_amdgcn_mfma_f32_32x32x16_bf16(ai[2 * nt], idf[0], zero16(), 0, 0, 0);
          di = __builtin_amdgcn_mfma_f32_32x32x16_bf16(ai[2 * nt + 1], idf[1], di, 0, 0, 0);
#pragma unroll
          for (int k2 = 0; k2 < 2; ++k2) {
            u32x4 a, b; a.x = cvtpk(dr[k2 * 8 + 0], dr[k2 * 8 + 1]); a.y = cvtpk(dr[k2 * 8 + 2], dr[k2 * 8 + 3]); a.z = cvtpk(dr[k2 * 8 + 4], dr[k2 * 8 + 5]); a.w = cvtpk(dr[k2 * 8 + 6], dr[k2 * 8 + 7]);
            b.x = cvtpk(di[k2 * 8 + 0], di[k2 * 8 + 1]); b.y = cvtpk(di[k2 * 8 + 2], di[k2 * 8 + 3]); b.z = cvtpk(di[k2 * 8 + 4], di[k2 * 8 + 5]); b.w = cvtpk(di[k2 * 8 + 6], di[k2 * 8 + 7]);
            zr[nt][k2] = __builtin_bit_cast(bf16x8, a); zi[nt][k2] = __builtin_bit_cast(bf16x8, b);
          }
        }
      }
#pragma unroll
      for (int k2 = 0; k2 < 2; ++k2) {
        const int ks = mt * 2 + k2;
        bf16x8 fc[2], fs[2], fn[2];
#pragma unroll
        for (int ni = 0; ni < 2; ++ni) {
          const size_t fo = ((size_t)(((nb * KS + ks) * 2 + ni) * 2) * 64 + lane) * 8;
          fc[ni] = *(const bf16x8*)(ftab + fo); fs[ni] = *(const bf16x8*)(ftab + fo + 512);
          u32x4 t = __builtin_bit_cast(u32x4, fs[ni]); t.x ^= 0x80008000u; t.y ^= 0x80008000u; t.z ^= 0x80008000u; t.w ^= 0x80008000u; fn[ni] = __builtin_bit_cast(bf16x8, t);
        }
#pragma unroll
        for (int mi = 0; mi < 2; ++mi)
#pragma unroll
          for (int ni = 0; ni < 2; ++ni) {
            yr[mi][ni] = __builtin_amdgcn_mfma_f32_32x32x16_bf16(zr[mi][k2], fc[ni], yr[mi][ni], 0, 0, 0);
            yr[mi][ni] = __builtin_amdgcn_mfma_f32_32x32x16_bf16(zi[mi][k2], fs[ni], yr[mi][ni], 0, 0, 0);
            yi[mi][ni] = __builtin_amdgcn_mfma_f32_32x32x16_bf16(zi[mi][k2], fc[ni], yi[mi][ni], 0, 0, 0);
            yi[mi][ni] = __builtin_amdgcn_mfma_f32_32x32x16_bf16(zr[mi][k2], fn[ni], yi[mi][ni], 0, 0, 0);
          }
      }
    }
    const int tsh = (S == 4096) ? 1 : 0;
    u16* ybase = y1 + (size_t)seqbase * 1024;
    LAS unsigned char* wl = lds + wid * 16384;
#pragma unroll
    for (int ni = 0; ni < 2; ++ni) {
      const int sb = nb * 64 + ni * 32 + l32;
#pragma unroll
      for (int mi = 0; mi < 2; ++mi)
#pragma unroll
        for (int r4 = 0; r4 < 4; ++r4) {
          const int tl0 = mi * 32 + 8 * r4 + 4 * hi;
          float orr[4], oii[4];
#pragma unroll
          for (int e = 0; e < 4; ++e) {
            const int idx = ((sb * (tl0 + e)) << tsh) & 8191;
            const float rev = (float)idx * (1.f / 8192.f);
            const float tc = __builtin_amdgcn_cosf(rev), ts = __builtin_amdgcn_sinf(rev);
            const float a = yr[mi][ni][r4 * 4 + e], b = yi[mi][ni][r4 * 4 + e];
            orr[e] = a * tc + b * ts; oii[e] = b * tc - a * ts;
          }
          const int rl = ni * 32 + l32;
          u32x2 w; w.x = cvtpk(orr[0], orr[1]); w.y = cvtpk(orr[2], orr[3]); *(LAS u32x2*)(wl + rl * 256 + ((((tl0 >> 2)) ^ (rl & 31)) << 3)) = w;
          w.x = cvtpk(oii[0], oii[1]); w.y = cvtpk(oii[2], oii[3]); *(LAS u32x2*)(wl + rl * 256 + (((16 + (tl0 >> 2)) ^ (rl & 31)) << 3)) = w;
        }
    }
    {
      u16* yblk = ybase + ((size_t)c * (S >> 6) + nb * 64) * 128;
      const int cc = lane & 15, rq = lane >> 4;
#pragma unroll 4
      for (int rd = 0; rd < 16; ++rd) {
        const int r = rd * 4 + rq;
        u32x4 v = *(const LAS u32x4*)(wl + r * 256 + ((cc ^ ((r & 31) >> 1)) << 4));
        if (r & 1) { u32x4 t; t.x = v.z; t.y = v.w; t.z = v.x; t.w = v.y; v = t; }
        __builtin_nontemporal_store(v, (u32x4*)(yblk + (size_t)r * 128 + cc * 8));
      }
    }
  }
  xcd_barrier(gbar);

  float att_B; bool att_online;
  { float wq = fabsf(p.q_norm[lane]), wk = fabsf(p.k_norm[lane]);
#pragma unroll
    for (int o = 1; o < 64; o <<= 1) { wq = fmaxf(wq, __shfl_xor(wq, o)); wk = fmaxf(wk, __shfl_xor(wk, o)); }
    att_B = __uint_as_float(__builtin_amdgcn_readfirstlane(__float_as_uint(64.f * QSCALE * wq * wk))); att_online = !(att_B < 40.f); }
  for (int u = vb; u < 3072; u += G) {
    if (u < 1536) {
      int seq, qblk, h;
      if (u < 512) { seq = 8 + (u >> 8); const int rem = u & 255; qblk = (rem >> 2) & 31; h = (rem >> 7) * 4 + (rem & 3); } else { const int v = u - 512; seq = v >> 7; const int rem = v & 127; qblk = (rem >> 2) & 15; h = (rem >> 6) * 4 + (rem & 3); }
      int seqbase, S; seq_info(seq, seqbase, S);
      const int kvh = h >> 2, NTL = S >> 6;
      const int qtoken = seqbase + qblk * 256 + wid * 32 + l32;
      bf16x8 qf[4];
#pragma unroll
      for (int ks = 0; ks < 4; ++ks) qf[ks] = *(const bf16x8*)(qb + (size_t)qtoken * 512 + h * 64 + ks * 16 + hi * 8);
      const int c = tid & 7, r0 = tid >> 3;
      const u16* kp = kb + (size_t)(seqbase + r0) * 128 + kvh * 64 + c * 8;
      const u16* vp = vt + (size_t)seqbase * 128 + (size_t)(kvh * 64 + r0) * S + c * 8;
      const unsigned woff = r0 * 128 + ((c ^ ((r0 >> 1) & 7)) << 4);
      const int sw = (l32 >> 1) & 7;
      u32x4 kr = *(const u32x4*)kp, vr = *(const u32x4*)vp;
      *(LAS u32x4*)(lds + woff) = kr; *(LAS u32x4*)(lds + 8192 + woff) = vr;
      __syncthreads();
      f32x16 o[2]; o[0] = zero16(); o[1] = zero16();
      float m = 0.f, lsum = 0.f;
      for (int kt = 0; kt < NTL; ++kt) {
        const unsigned bo = (kt & 1) * 16384;
        if (kt + 1 < NTL) { kr = *(const u32x4*)(kp + (size_t)(kt + 1) * 64 * 128); vr = *(const u32x4*)(vp + (size_t)(kt + 1) * 64); }
        f32x16 st[2];
        bf16x8 kf[8];
#pragma unroll
        for (int ks = 0; ks < 4; ++ks) {
          const unsigned co = (unsigned)(((ks * 2 + hi) ^ sw) << 4);
#pragma unroll
          for (int mt = 0; mt < 2; ++mt) kf[ks * 2 + mt] = *(const LAS bf16x8*)(lds + bo + (mt * 32 + l32) * 128 + co);
        }
        __builtin_amdgcn_sched_barrier(0);
#pragma unroll
        for (int ks = 0; ks < 4; ++ks)
#pragma unroll
          for (int mt = 0; mt < 2; ++mt) {
            if (ks == 0) st[mt] = __builtin_amdgcn_mfma_f32_32x32x16_bf16(kf[ks * 2 + mt], qf[ks], zero16(), 0, 0, 0);
            else st[mt] = __builtin_amdgcn_mfma_f32_32x32x16_bf16(kf[ks * 2 + mt], qf[ks], st[mt], 0, 0, 0);
          }
        if (att_online) {
#pragma unroll
        for (int r = 0; r < 16; ++r) { st[0][r] -= m; st[1][r] -= m; }
        float ra = __builtin_fmaxf(__builtin_fmaxf(st[0][0], st[0][1]), st[0][2]), rb = __builtin_fmaxf(__builtin_fmaxf(st[1][0], st[1][1]), st[1][2]);
#pragma unroll
        for (int r = 3; r < 15; r += 2) { ra = __builtin_fmaxf(__builtin_fmaxf(ra, st[0][r]), st[0][r + 1]); rb = __builtin_fmaxf(__builtin_fmaxf(rb, st[1][r]), st[1][r + 1]); }
        float rm = __builtin_fmaxf(__builtin_fmaxf(ra, rb), __builtin_fmaxf(st[0][15], st[1][15]));
        { const auto rr = __builtin_amdgcn_permlane32_swap(__float_as_uint(rm), __float_as_uint(rm), false, false); rm = __builtin_fmaxf(__uint_as_float(rr[0]), __uint_as_float(rr[1])); }
        if (kt == 0 || __any(rm > 8.f)) {
          const float dl = (kt == 0) ? rm : fmaxf(rm, 0.f);
          m += dl;
          const float f = __builtin_amdgcn_exp2f(-dl);
          lsum *= f;
#pragma unroll
          for (int r = 0; r < 16; ++r) { st[0][r] -= dl; st[1][r] -= dl; o[0][r] *= f; o[1][r] *= f; }
        }
        }
        f32x2 pa = {0.f, 0.f}, pb = {0.f, 0.f};
#pragma unroll
        for (int r = 0; r < 16; r += 2) { const float e0 = __builtin_amdgcn_exp2f(st[0][r]); st[0][r] = e0; const float e1 = __builtin_amdgcn_exp2f(st[1][r]); st[1][r] = e1;
          const float e2 = __builtin_amdgcn_exp2f(st[0][r + 1]); st[0][r + 1] = e2; const float e3 = __builtin_amdgcn_exp2f(st[1][r + 1]); st[1][r + 1] = e3;
          f32x2 t0 = {e0, e2}, t1 = {e1, e3}; pa += t0; pb += t1; }
        pa += pb; lsum += pa.x + pa.y;
#pragma unroll
        for (int kk = 0; kk < 4; ++kk) {
          const int mt = kk >> 1, hb = (kk & 1) * 8;
          u32x4 pw; pw.x = cvtpk(st[mt][hb + 0], st[mt][hb + 1]); pw.y = cvtpk(st[mt][hb + 2], st[mt][hb + 3]); pw.z = cvtpk(st[mt][hb + 4], st[mt][hb + 5]); pw.w = cvtpk(st[mt][hb + 6], st[mt][hb + 7]);
          const bf16x8 pf = __builtin_bit_cast(bf16x8, pw);
          const unsigned cv = (unsigned)(((kk * 2 + hi) ^ sw) << 4);
#pragma unroll
          for (int dt = 0; dt < 2; ++dt) {
            const bf16x8 vf = *(const LAS bf16x8*)(lds + bo + 8192 + (dt * 32 + l32) * 128 + cv);
            o[dt] = __builtin_amdgcn_mfma_f32_32x32x16_bf16(vf, pf, o[dt], 0, 0, 0);
          }
        }
        if (kt + 1 < NTL) { const unsigned bn = ((kt + 1) & 1) * 16384; *(LAS u32x4*)(lds + bn + woff) = kr; *(LAS u32x4*)(lds + bn + 8192 + woff) = vr; }
        __syncthreads();
      }
      lsum += __shfl_xor(lsum, 32);
      const float inv = 1.f / lsum;
      {
        LAS unsigned char* wl = lds + 65536 + wid * 4096;
#pragma unroll
        for (int dt = 0; dt < 2; ++dt)
#pragma unroll
          for (int r4 = 0; r4 < 4; ++r4) {
            const int q = (dt * 32 + 8 * r4 + 4 * hi) >> 2;
            u32x2 w; w.x = cvtpk(o[dt][r4 * 4 + 0] * inv, o[dt][r4 * 4 + 1] * inv); w.y = cvtpk(o[dt][r4 * 4 + 2] * inv, o[dt][r4 * 4 + 3] * inv);
            *(LAS u32x2*)(wl + l32 * 128 + ((q ^ (l32 & 15)) << 3)) = w;
          }
        const int cc = lane & 7, rq = lane >> 3;
        const int tok0 = seqbase + qblk * 256 + wid * 32;
#pragma unroll
        for (int rd = 0; rd < 4; ++rd) {
          const int r = rd * 8 + rq;
          u32x4 v = *(const LAS u32x4*)(wl + r * 128 + ((cc ^ ((r & 15) >> 1)) << 4));
          if (r & 1) { u32x4 t; t.x = v.z; t.y = v.w; t.z = v.x; t.w = v.y; v = t; }
          const u32x4 g = *(const u32x4*)(ga + (size_t)(tok0 + r) * 512 + h * 64 + cc * 8);
          u32x4 w;
          w.x = cvtpk(__uint_as_float(v.x << 16) * __uint_as_float(g.x << 16), __uint_as_float(v.x & 0xffff0000u) * __uint_as_float(g.x & 0xffff0000u));
          w.y = cvtpk(__uint_as_float(v.y << 16) * __uint_as_float(g.y << 16), __uint_as_float(v.y & 0xffff0000u) * __uint_as_float(g.y & 0xffff0000u));
          w.z = cvtpk(__uint_as_float(v.z << 16) * __uint_as_float(g.z << 16), __uint_as_float(v.z & 0xffff0000u) * __uint_as_float(g.z & 0xffff0000u));
          w.w = cvtpk(__uint_as_float(v.w << 16) * __uint_as_float(g.w << 16), __uint_as_float(v.w & 0xffff0000u) * __uint_as_float(g.w & 0xffff0000u));
          *(u32x4*)(yb + (size_t)(tok0 + r) * 1024 + h * 64 + cc * 8) = w;
        }
      }
    } else {
      const int v = u - 1536; int seq, sb, gp;
      if (v < 512) { seq = 8 + (v >> 8); const int rem = v & 255; sb = rem >> 1; gp = rem & 1; } else { const int w = v - 512; seq = w >> 7; const int rem = w & 127; sb = rem >> 1; gp = rem & 1; }
      int seqbase, S; seq_info(seq, seqbase, S);
      const int H = S >> 6;
      const int cch = gp * 256 + wid * 32 + l32;
      const u16* arow = y1 + (size_t)seqbase * 1024 + ((size_t)cch * H + sb) * 128 + 8 * hi;
      f32x16 acc[2]; acc[0] = zero16(); acc[1] = zero16();
#pragma unroll
      for (int ks = 0; ks < 8; ++ks) {
        const bf16x8 af = *(const bf16x8*)(arow + ks * 16);
#pragma unroll
        for (int nt = 0; nt < 2; ++nt) {
          const bf16x8 bf = *(const bf16x8*)(f2t + ((size_t)(ks * 2 + nt) * 64 + lane) * 8);
          acc[nt] = __builtin_amdgcn_mfma_f32_32x32x16_bf16(af, bf, acc[nt], 0, 0, 0);
        }
      }
      const float nrm = (S == 4096) ? (1.f / 64.f) : 0.011048543456039806f;
      {
        LAS unsigned char* wl = lds + 65536 + wid * 4096;
#pragma unroll
        for (int nt = 0; nt < 2; ++nt) {
          const int rl = nt * 32 + l32;
#pragma unroll
          for (int r4 = 0; r4 < 4; ++r4) {
            const f32x4 bias = *(const f32x4*)(p.b_f + gp * 256 + wid * 32 + 8 * r4 + 4 * hi);
            u32x2 w; w.x = cvtpk(acc[nt][r4 * 4 + 0] * nrm + bias.x, acc[nt][r4 * 4 + 1] * nrm + bias.y); w.y = cvtpk(acc[nt][r4 * 4 + 2] * nrm + bias.z, acc[nt][r4 * 4 + 3] * nrm + bias.w);
            *(LAS u32x2*)(wl + rl * 64 + ((((8 * r4 + 4 * hi) >> 2) ^ (rl & 7)) << 3)) = w;
          }
        }
        const int cc = lane & 3, rq = lane >> 2;
#pragma unroll
        for (int rd = 0; rd < 4; ++rd) {
          const int r = rd * 16 + rq;
          const int token = seqbase + r * H + sb;
          u32x4 v = *(const LAS u32x4*)(wl + r * 64 + ((cc ^ ((r & 7) >> 1)) << 4));
          if (r & 1) { u32x4 t; t.x = v.z; t.y = v.w; t.z = v.x; t.w = v.y; v = t; }
          const int ch = gp * 256 + wid * 32 + cc * 8;
          const u32x4 g = *(const u32x4*)(gf + (size_t)token * 512 + ch);
          u32x4 w;
          w.x = cvtpk(__uint_as_float(v.x << 16) * __uint_as_float(g.x << 16), __uint_as_float(v.x & 0xffff0000u) * __uint_as_float(g.x & 0xffff0000u));
          w.y = cvtpk(__uint_as_float(v.y << 16) * __uint_as_float(g.y << 16), __uint_as_float(v.y & 0xffff0000u) * __uint_as_float(g.y & 0xffff0000u));
          w.z = cvtpk(__uint_as_float(v.z << 16) * __uint_as_float(g.z << 16), __uint_as_float(v.z & 0xffff0000u) * __uint_as_float(g.z & 0xffff0000u));
          w.w = cvtpk(__uint_as_float(v.w << 16) * __uint_as_float(g.w << 16), __uint_as_float(v.w & 0xffff0000u) * __uint_as_float(g.w & 0xffff0000u));
          *(u32x4*)(yb + (size_t)token * 1024 + 512 + ch) = w;
        }
      }
    }
  }
  xcd_barrier(gbar);

  {
    const int wy = wid >> 2, wx = wid & 3;
    for (int u = vb; u < 192 * 4; u += G) {
      const int mt = u >> 2, nt = u & 3;
      f32x16 acc[4][2];
#pragma unroll
      for (int a = 0; a < 4; ++a)
#pragma unroll
        for (int b = 0; b < 2; ++b) acc[a][b] = zero16();
      gemm_mainloop(lds, wot + (size_t)nt * 256 * DM, yb + (size_t)mt * 256 * DM, acc, tid);
#pragma unroll
      for (int ni = 0; ni < 2; ++ni) {
        const int token = mt * 256 + wx * 64 + ni * 32 + l32;
        u16* yrow = yw + (size_t)token * DM;
#pragma unroll
        for (int mi = 0; mi < 4; ++mi)
#pragma unroll
          for (int r4 = 0; r4 < 4; ++r4) {
            const int col = nt * 256 + wy * 128 + mi * 32 + 8 * r4 + 4 * hi;
            u32x2 w; w.x = cvtpk(acc[mi][ni][r4 * 4 + 0], acc[mi][ni][r4 * 4 + 1]); w.y = cvtpk(acc[mi][ni][r4 * 4 + 2], acc[mi][ni][r4 * 4 + 3]);
            stage_put(lds, wx * 64 + ni * 32 + l32, wy * 128 + mi * 32 + 8 * r4 + 4 * hi, w);
          }
      }
      stage_flush(lds, yw + (size_t)mt * 256 * DM + nt * 256, DM, wid, lane);
    }
  }
  xcd_barrier(gbar);

  for (int row = gw; row < NTOK; row += NW) {
    const float* xr = (row < NPROMPT) ? p.x_prompt + (size_t)row * DM : p.x_sample + (size_t)(row - NPROMPT) * DM;
    const u32x2* yr = (const u32x2*)(yw + (size_t)row * DM);
    f32x4 v[4]; float ss = 0.f;
#pragma unroll
    for (int j = 0; j < 4; ++j) {
      const f32x4 xv = __builtin_nontemporal_load((const f32x4*)xr + lane + 64 * j); const u32x2 y = yr[lane + 64 * j];
      v[j].x = xv.x + __uint_as_float(y.x << 16); v[j].y = xv.y + __uint_as_float(y.x & 0xffff0000u); v[j].z = xv.z + __uint_as_float(y.y << 16); v[j].w = xv.w + __uint_as_float(y.y & 0xffff0000u);
      ss += v[j].x * v[j].x + v[j].y * v[j].y + v[j].z * v[j].z + v[j].w * v[j].w;
    }
#pragma unroll
    for (int o = 1; o < 64; o <<= 1) ss += __shfl_xor(ss, o);
    const float rn = rsqrtf(ss * (1.f / DM) + EPS);
    f32x4* orow = (f32x4*)(p.out + (size_t)row * DM);
#pragma unroll
    for (int j = 0; j < 4; ++j) {
      const f32x4 w = ((const f32x4*)p.final_norm)[lane + 64 * j]; f32x4 z = v[j];
      z.x *= rn * w.x; z.y *= rn * w.y; z.z *= rn * w.z; z.w *= rn * w.w; orow[lane + 64 * j] = z;
    }
  }
}

extern "C" void kernel_launch(void* const* d_in, const int* in_sizes, int n_in, void* d_out, int out_size, void* d_ws, size_t ws_size, hipStream_t stream) {
  static int grid_blocks = 0;
  if (!grid_blocks) {
    int dev = 0, cus = 0, per_cu = 0;
    hipGetDevice(&dev);
    hipDeviceGetAttribute(&cus, hipDeviceAttributeMultiprocessorCount, dev);
    hipFuncSetAttribute((const void*)fwd_kernel, hipFuncAttributeMaxDynamicSharedMemorySize, LDS_BYTES);
    hipOccupancyMaxActiveBlocksPerMultiprocessor(&per_cu, (const void*)fwd_kernel, NTHR, LDS_BYTES);
    if (per_cu < 1) per_cu = 1;
    if (per_cu > 1) per_cu = 1;
    grid_blocks = cus * per_cu;
  }
  hipMemsetAsync((char*)d_ws + OFF_BAR, 0, 16384, stream);
  Params p{};
  p.x_prompt = (const float*)d_in[0]; p.x_sample = (const float*)d_in[1]; p.ln_w = (const float*)d_in[2]; p.w_in = (const float*)d_in[3];
  p.q_norm = (const float*)d_in[4]; p.k_norm = (const float*)d_in[5]; p.w_f = (const float*)d_in[6]; p.b_f = (const float*)d_in[7];
  p.w_out = (const float*)d_in[8]; p.final_norm = (const float*)d_in[9];
  p.out = (float*)d_out; p.ws = (unsigned char*)d_ws;
  void* args[] = {&p};
  hipError_t e = hipLaunchCooperativeKernel((const void*)fwd_kernel, dim3(grid_blocks), dim3(NTHR), args, LDS_BYTES, stream);
  if (e != hipSuccess) fprintf(stderr, "cooperative launch failed: %s (grid %d)\n", hipGetErrorString(e), grid_blocks);
}
```

```cpp
#include <hip/hip_runtime.h>
#include <hip/hip_cooperative_groups.h>
#include <cstdio>
#include <cstdint>
namespace cg = cooperative_groups;

typedef unsigned short u16;
typedef short bf16x8 __attribute__((ext_vector_type(8)));
typedef float f32x16 __attribute__((ext_vector_type(16)));
typedef float f32x4 __attribute__((ext_vector_type(4)));
typedef float f32x2 __attribute__((ext_vector_type(2)));
typedef unsigned u32x4 __attribute__((ext_vector_type(4)));
typedef unsigned u32x2 __attribute__((ext_vector_type(2)));
typedef __bf16 bf16x2_t __attribute__((ext_vector_type(2)));
#define LAS __attribute__((address_space(3)))

constexpr int DM = 1024, NTOK = 49152, NPROMPT = 32768, N1 = 2816, WIN_LD = 2304;
constexpr float EPS = 1e-6f;
constexpr float QSCALE = 0.125f * 1.4426950408889634f;
constexpr size_t MiB = 1u << 20, KiB = 1u << 10;
constexpr size_t OFF_XB = 0;
constexpr size_t OFF_RINV = 96 * MiB;
constexpr size_t OFF_ROWSS = 96 * MiB + 256 * KiB;
constexpr size_t OFF_ROPE = 96 * MiB + 512 * KiB;
constexpr size_t OFF_TW = 96 * MiB + 576 * KiB;
constexpr size_t OFF_F1A = 96 * MiB + 640 * KiB;
constexpr size_t OFF_F1B = 96 * MiB + 704 * KiB;
constexpr size_t OFF_F2 = 96 * MiB + 768 * KiB;
constexpr size_t OFF_MF = 97 * MiB;
constexpr size_t OFF_W1T = 98 * MiB;
constexpr size_t OFF_WOT = 104 * MiB;
constexpr size_t OFF_Q = 112 * MiB;
constexpr size_t OFF_K = 160 * MiB;
constexpr size_t OFF_VT = 172 * MiB;
constexpr size_t OFF_GA = 184 * MiB;
constexpr size_t OFF_GF = 232 * MiB;
constexpr size_t OFF_YB = 280 * MiB;
constexpr size_t OFF_BAR = 96 * MiB + 832 * KiB;
constexpr int LDS_MAIN = 131072, LDS_BYTES = LDS_MAIN + 64;
constexpr int NTHR = 512, NWAVE = 8;

struct Params {
  const float *x_prompt, *x_sample, *ln_w, *w_in, *q_norm, *k_norm, *w_f, *b_f, *w_out, *final_norm;
  float* out; unsigned char* ws;
};

__device__ __forceinline__ unsigned cvtpk(float lo, float hi) { f32x2 v = {lo, hi}; bf16x2_t b = __builtin_convertvector(v, bf16x2_t); return __builtin_bit_cast(unsigned, b); }
__device__ __forceinline__ float bf2f(unsigned short h) { return __uint_as_float(((unsigned)h) << 16); }
__device__ __forceinline__ float silu(float v) { return v * __builtin_amdgcn_rcpf(1.f + __builtin_amdgcn_exp2f(-1.4426950408889634f * v)); }
__device__ __forceinline__ void seq_info(int seq, int& seqbase, int& S) { if (seq < 8) { seqbase = seq * 4096; S = 4096; } else { seqbase = NPROMPT + (seq - 8) * 8192; S = 8192; } }
__device__ __forceinline__ void seq_of_row(int row, int& seqbase, int& S) { if (row < NPROMPT) { seqbase = row & ~4095; S = 4096; } else { seqbase = NPROMPT + ((row - NPROMPT) & ~8191); S = 8192; } }
__device__ __forceinline__ f32x16 zero16() { f32x16 z; for (int i = 0; i < 16; ++i) z[i] = 0.f; return z; }


#define XB_TMO      128
#define XB_XCNT(j)  (256  + 64 * (j))
#define XB_XSUB(j)  (1280 + 64 * (j))
#define XB_XGEN(j)  (2304 + 64 * (j))
#define XB_TOP      3328
#define XB_TOPGEN   3392
#define XCD_BAR_WORDS 3456
#define XB_SPIN_CAP (1u << 18)
__device__ __forceinline__ unsigned xb_ld(unsigned* p)              { return __hip_atomic_load(p, __ATOMIC_RELAXED, __HIP_MEMORY_SCOPE_AGENT); }
__device__ __forceinline__ unsigned xb_add(unsigned* p, unsigned v) { return __hip_atomic_fetch_add(p, v, __ATOMIC_RELAXED, __HIP_MEMORY_SCOPE_AGENT); }
__device__ __forceinline__ unsigned xb_xcc_id() { return (unsigned)__builtin_amdgcn_s_getreg((3 << 11) | 20) & 0xFu; }
#define XB_SPIN(cond, bar) do { unsigned _sp = 0; while (cond) { __builtin_amdgcn_s_sleep(1); \
    if ((++_sp & 255u) == 0u) { if (xb_ld(&(bar)[XB_TMO])) break; if (_sp > XB_SPIN_CAP) { atomicAdd(&(bar)[XB_TMO], 1u); break; } } } } while (0)
struct XcdBarrier { unsigned* bar; unsigned x; volatile LAS unsigned* st; };
__device__ __forceinline__ XcdBarrier xcd_barrier_post(unsigned* bar, volatile LAS unsigned* st) {
  XcdBarrier b; b.bar = bar; b.x = xb_xcc_id(); b.st = st;
  if (threadIdx.x == 0) (void)xb_add(&bar[XB_XCNT(b.x)], 1u);
  return b;
}
__device__ __forceinline__ void xcd_barrier_complete(unsigned* bar, unsigned x, unsigned& nloc, unsigned& nx) {
  const unsigned G = gridDim.x * gridDim.y * gridDim.z;
  unsigned sum, cnt, mine, sp = 0u;
  for (;;) {
    sum = 0u; cnt = 0u; mine = 0u;
#pragma unroll
    for (unsigned j = 0; j < 16; ++j) { const unsigned c = xb_ld(&bar[XB_XCNT(j)]); sum += c; cnt += (c > 0u) ? 1u : 0u; mine = (j == x) ? c : mine; }
    if (sum == G) break;
    __builtin_amdgcn_s_sleep(1);
    if ((++sp & 255u) == 0u) { if (xb_ld(&bar[XB_TMO])) break; if (sp > XB_SPIN_CAP) { atomicAdd(&bar[XB_TMO], 1u); break; } }
  }
  nloc = mine > 0u ? mine : 1u; nx = cnt > 0u ? cnt : 1u;
}
__device__ __forceinline__ void xcd_barrier(const XcdBarrier& b) {
  asm volatile("s_waitcnt vmcnt(0)" ::: "memory");
  __syncthreads();
  if (threadIdx.x == 0) {
    unsigned* bar = b.bar;
    __builtin_amdgcn_s_waitcnt(0);
    unsigned nloc = b.st[0], nx = b.st[1];
    if (nloc == 0u) { xcd_barrier_complete(bar, b.x, nloc, nx); b.st[0] = nloc; b.st[1] = nx; }
    const unsigned old = xb_add(&bar[XB_XSUB(b.x)], 1u);
    const unsigned gen = old / nloc;
    if (old + 1u == (gen + 1u) * nloc) {
      __builtin_amdgcn_fence(__ATOMIC_RELEASE, "agent");
      asm volatile("s_waitcnt vmcnt(0)" ::: "memory");
      const unsigned og = xb_add(&bar[XB_TOP], 1u);
      const unsigned tg = og / nx;
      if (og + 1u == (tg + 1u) * nx) xb_add(&bar[XB_TOPGEN], 1u);
      else XB_SPIN(xb_ld(&bar[XB_TOPGEN]) == tg, bar);
      __builtin_amdgcn_fence(__ATOMIC_ACQUIRE, "agent");
      xb_add(&bar[XB_XGEN(b.x)], 1u);
      asm volatile("s_waitcnt vmcnt(0)" ::: "memory");
    } else {
      XB_SPIN(xb_ld(&bar[XB_XGEN(b.x)]) == gen, bar);
      __builtin_amdgcn_fence(__ATOMIC_ACQUIRE, "agent");
      asm volatile("s_waitcnt vmcnt(0)" ::: "memory");
    }
  }
  __syncthreads();
}

__device__ __forceinline__ void gemm_mainloop(LAS unsigned char* lds, const u16* Xg, const u16* Yg, f32x16 (&acc)[4][2], int tid) {
  const int lane = tid & 63, wid = __builtin_amdgcn_readfirstlane(tid >> 6), wy = wid >> 2, wx = wid & 3, l32 = lane & 31, hi = lane >> 5;
  const int drow = wid * 16 + (lane >> 2), dch = (lane & 3) ^ ((drow >> 2) & 3);
  const u16* xp = Xg + (size_t)drow * 1024 + dch * 8;
  const u16* yp = Yg + (size_t)drow * 1024 + dch * 8;
  const int sw = (l32 >> 2) & 3;
  const unsigned xbase = (wy * 128 + l32) * 64, ybase = 16384 + (wx * 64 + l32) * 64;
  const unsigned ldsw = (unsigned)wid * 1024u;
#define GEMM_DMA(j_) do { const unsigned so_ = (unsigned)(((j_) & 3) * 32768); _Pragma("unroll") for (int i_ = 0; i_ < 2; ++i_) { \
    __builtin_amdgcn_global_load_lds((const unsigned*)(xp + (size_t)i_ * 128 * 1024 + (j_) * 32), (LAS unsigned*)(lds + so_ + ldsw + i_ * 8192), 16, 0, 0); \
    __builtin_amdgcn_global_load_lds((const unsigned*)(yp + (size_t)i_ * 128 * 1024 + (j_) * 32), (LAS unsigned*)(lds + so_ + 16384 + ldsw + i_ * 8192), 16, 0, 0); } } while (0)
  GEMM_DMA(0); GEMM_DMA(1); GEMM_DMA(2);
#pragma unroll 4
  for (int j = 0; j < 32; ++j) {
    const unsigned bo = (unsigned)((j & 3) * 32768);
    if (j < 30) asm volatile("s_waitcnt vmcnt(8) lgkmcnt(0)" ::: "memory");
    else if (j == 30) asm volatile("s_waitcnt vmcnt(4) lgkmcnt(0)" ::: "memory");
    else asm volatile("s_waitcnt vmcnt(0) lgkmcnt(0)" ::: "memory");
    __builtin_amdgcn_s_barrier();
    asm volatile("" ::: "memory");
    if (j + 3 < 32) GEMM_DMA(j + 3);
#pragma unroll
    for (int ks = 0; ks < 2; ++ks) {
      const unsigned co = (unsigned)(((ks * 2 + hi) ^ sw) << 4);
      bf16x8 xf[4], yf[2];
#pragma unroll
      for (int ni = 0; ni < 2; ++ni) yf[ni] = *(const LAS bf16x8*)(lds + bo + ybase + ni * 2048 + co);
#pragma unroll
      for (int mi = 0; mi < 4; ++mi) xf[mi] = *(const LAS bf16x8*)(lds + bo + xbase + mi * 2048 + co);
#pragma unroll
      for (int mi = 0; mi < 4; ++mi)
#pragma unroll
        for (int ni = 0; ni < 2; ++ni) acc[mi][ni] = __builtin_amdgcn_mfma_f32_32x32x16_bf16(xf[mi], yf[ni], acc[mi][ni], 0, 0, 0);
    }
  }
#undef GEMM_DMA
  asm volatile("s_waitcnt lgkmcnt(0)" ::: "memory");
  __builtin_amdgcn_s_barrier();
  asm volatile("" ::: "memory");
}


__device__ __forceinline__ void stage_put(LAS unsigned char* lds, int row, int col, u32x2 w) { *(LAS u32x2*)(lds + row * 512 + (((col >> 2) ^ (row & 63)) << 3)) = w; }
__device__ __forceinline__ void stage_flush(LAS unsigned char* lds, u16* dst, int ld, int wid, int lane) {
  __syncthreads();
  const int c = lane & 31, hh = lane >> 5;
#pragma unroll 2
  for (int rd = 0; rd < 16; ++rd) {
    const int r = rd * 16 + wid * 2 + hh;
    u32x4 v = *(const LAS u32x4*)(lds + r * 512 + ((c ^ ((r & 63) >> 1)) << 4));
    if (r & 1) { u32x4 t; t.x = v.z; t.y = v.w; t.z = v.x; t.w = v.y; v = t; }
    __builtin_nontemporal_store(v, (u32x4*)(dst + (size_t)r * ld + c * 8));
  }
  __syncthreads();
}

__global__ void __launch_bounds__(512, 2) fwd_kernel(Params p) {
  extern __shared__ __attribute__((aligned(16))) unsigned char smem[];
  LAS unsigned char* lds = (LAS unsigned char*)smem;
  cg::grid_group grid = cg::this_grid();
  if (p.ws == nullptr) grid.sync();
  volatile LAS unsigned* misc = (volatile LAS unsigned*)(lds + LDS_MAIN);
  if (threadIdx.x < 16) misc[threadIdx.x] = 0u;
  __syncthreads();
  const XcdBarrier gbar = xcd_barrier_post((unsigned*)(p.ws + OFF_BAR), misc);
  const int tid = threadIdx.x, lane = tid & 63, wid = __builtin_amdgcn_readfirstlane(tid >> 6), l32 = lane & 31, hi = lane >> 5;
  const int G = gridDim.x;
  const int vb = (G % 8 == 0) ? (int)((blockIdx.x % 8) * (G / 8) + blockIdx.x / 8) : (int)blockIdx.x;
  unsigned char* ws = p.ws;
  u16* xb = (u16*)(ws + OFF_XB); u16* y1 = (u16*)(ws + OFF_XB);
  float* rinv = (float*)(ws + OFF_RINV); float* rowss = (float*)(ws + OFF_ROWSS);
  float* rope = (float*)(ws + OFF_ROPE); float* tw = (float*)(ws + OFF_TW);
  u16* f1a = (u16*)(ws + OFF_F1A); u16* f1b = (u16*)(ws + OFF_F1B); u16* f2t = (u16*)(ws + OFF_F2);
  float* mf = (float*)(ws + OFF_MF);
  u16* w1t = (u16*)(ws + OFF_W1T); u16* wot = (u16*)(ws + OFF_WOT);
  u16* qb = (u16*)(ws + OFF_Q); u16* kb = (u16*)(ws + OFF_K); u16* vt = (u16*)(ws + OFF_VT);
  u16* ga = (u16*)(ws + OFF_GA); u16* gf = (u16*)(ws + OFF_GF); u16* yb = (u16*)(ws + OFF_YB);
  u16* yw = (u16*)(ws + OFF_GA);
  u16* zt = (u16*)p.out;
  unsigned* pcnt = (unsigned*)(ws + OFF_BAR) + 3584;
  const int gtid = blockIdx.x * NTHR + tid, NT_ = G * NTHR;
  const int gw = blockIdx.x * NWAVE + wid, NW = G * NWAVE;

  for (int row = gw; row < NTOK; row += NW) {
    const float* xr = (row < NPROMPT) ? p.x_prompt + (size_t)row * DM : p.x_sample + (size_t)(row - NPROMPT) * DM;
    f32x4 v[4]; float ss = 0.f;
#pragma unroll
    for (int j = 0; j < 4; ++j) { v[j] = __builtin_nontemporal_load((const f32x4*)xr + lane + 64 * j); ss += v[j].x * v[j].x + v[j].y * v[j].y + v[j].z * v[j].z + v[j].w * v[j].w; }
#pragma unroll
    for (int o = 1; o < 64; o <<= 1) ss += __shfl_xor(ss, o);
    u32x2* o8 = (u32x2*)(xb + (size_t)row * DM);
#pragma unroll
    for (int j = 0; j < 4; ++j) { u32x2 w; w.x = cvtpk(v[j].x, v[j].y); w.y = cvtpk(v[j].z, v[j].w); o8[lane + 64 * j] = w; }
    if (lane == 0) rinv[row] = rsqrtf(ss * (1.f / DM) + EPS);
  }
  for (int i = gtid; i < 8192 + 32768 + 8192; i += NT_) {
    float val; u16* dst;
    if (i < 8192 + 32768) {
      const bool big = i >= 8192; const int e = big ? i - 8192 : i; const int H = big ? 128 : 64, KS = big ? 8 : 4;
      const int j = e & 7, ln = (e >> 3) & 63, cs = (e >> 9) & 1, nt = (e >> 10) & 1, rest = e >> 11; const int ks = rest % KS, nb = rest / KS;
      const int sb = nb * 64 + nt * 32 + (ln & 31), th = ks * 16 + 8 * (j >> 2) + 4 * (ln >> 5) + (j & 3);
      float s, c; sincospif((float)((sb * th) & (H - 1)) * (2.f / (float)H), &s, &c); val = cs ? s : c; dst = (big ? f1b : f1a) + e;
    } else {
      const int e = i - 8192 - 32768; const int j = e & 7, ln = (e >> 3) & 63, nt = (e >> 9) & 1, ks = e >> 10;
      const int sa = nt * 32 + (ln & 31), kidx = ks * 16 + 8 * (ln >> 5) + j, part = kidx >> 6, tl = kidx & 63;
      float s, c; sincospif((float)((sa * tl) & 63) * (1.f / 32.f), &s, &c); val = part ? s : c; dst = f2t + e;
    }
    *dst = (u16)(cvtpk(val, 0.f) & 0xffffu);
  }
  for (int i = gtid; i < 128 * 1792; i += NT_) {
    const int k8 = i / 1792, jn = i % 1792; const int n = jn < 1280 ? jn : jn + 1024, src = jn < 1280 ? jn : jn + 512;
    float v[8];
#pragma unroll
    for (int e = 0; e < 8; ++e) v[e] = p.ln_w[k8 * 8 + e] * p.w_in[(size_t)(k8 * 8 + e) * WIN_LD + src];
    u32x4 w; w.x = cvtpk(v[0], v[1]); w.y = cvtpk(v[2], v[3]); w.z = cvtpk(v[4], v[5]); w.w = cvtpk(v[6], v[7]);
    *(u32x4*)(w1t + (size_t)n * DM + k8 * 8) = w;
  }
  for (int i = gtid; i < 128 * 1024; i += NT_) {
    const int k8 = i >> 10, n = i & 1023; float v[8];
#pragma unroll
    for (int e = 0; e < 8; ++e) v[e] = p.w_out[(size_t)(k8 * 8 + e) * DM + n];
    u32x4 w; w.x = cvtpk(v[0], v[1]); w.y = cvtpk(v[2], v[3]); w.z = cvtpk(v[4], v[5]); w.w = cvtpk(v[6], v[7]);
    *(u32x4*)(wot + (size_t)n * DM + k8 * 8) = w;
  }
  for (int i2 = gtid; i2 < 2 * 4 * 128 * 128; i2 += NT_) {
    const int which = i2 >> 16, i = i2 & 65535;
    const int c = i & 127, cp = (i >> 7) & 127, g = i >> 14; float a = 0.f;
    if (which == 0) { for (int j = 0; j < 128; ++j) a += __builtin_amdgcn_cosf((float)((cp * j) & 127) * (1.f / 128.f)) * p.w_f[(size_t)(g * 128 + j) * 128 + c]; mf[i] = a * 0.08838834764831845f; }
    else { for (int j = 0; j < 128; ++j) a += __builtin_amdgcn_sinf((float)((cp * j) & 127) * (1.f / 128.f)) * p.w_f[(size_t)(g * 128 + j) * 128 + c]; mf[65536 + i] = -a * 0.08838834764831845f; }
  }
  xcd_barrier(gbar);

  for (int u = blockIdx.x; u < 128; u += G) {
    const int g = u >> 5, d0 = (u & 31) * 32;
    LAS float* wt = (LAS float*)lds;
#pragma unroll
    for (int i = 0; i < 8; ++i) { const int idx = tid + NTHR * i, dd = idx >> 7, cc = idx & 127; wt[cc * 32 + dd] = p.w_in[(size_t)(d0 + dd) * WIN_LD + 1280 + g * 128 + cc] * p.ln_w[d0 + dd]; }
    __syncthreads();
    const int c = tid & 127, q4 = tid >> 7;
    float a1[8], a2[8];
#pragma unroll
    for (int e = 0; e < 8; ++e) { a1[e] = 0.f; a2[e] = 0.f; }
    for (int cp = 0; cp < 128; ++cp) {
      const float m1 = mf[(g * 128 + cp) * 128 + c], m2 = mf[65536 + (g * 128 + cp) * 128 + c];
      const f32x4 w0 = *(const LAS f32x4*)(wt + cp * 32 + q4 * 8), w1 = *(const LAS f32x4*)(wt + cp * 32 + q4 * 8 + 4);
      a1[0] += w0.x * m1; a1[1] += w0.y * m1; a1[2] += w0.z * m1; a1[3] += w0.w * m1; a1[4] += w1.x * m1; a1[5] += w1.y * m1; a1[6] += w1.z * m1; a1[7] += w1.w * m1;
      a2[0] += w0.x * m2; a2[1] += w0.y * m2; a2[2] += w0.z * m2; a2[3] += w0.w * m2; a2[4] += w1.x * m2; a2[5] += w1.y * m2; a2[6] += w1.z * m2; a2[7] += w1.w * m2;
    }
    u32x4 w; w.x = cvtpk(a1[0], a1[1]); w.y = cvtpk(a1[2], a1[3]); w.z = cvtpk(a1[4], a1[5]); w.w = cvtpk(a1[6], a1[7]);
    *(u32x4*)(w1t + (size_t)(1280 + g * 128 + c) * DM + d0 + q4 * 8) = w;
    w.x = cvtpk(a2[0], a2[1]); w.y = cvtpk(a2[2], a2[3]); w.z = cvtpk(a2[4], a2[5]); w.w = cvtpk(a2[6], a2[7]);
    *(u32x4*)(w1t + (size_t)(1792 + g * 128 + c) * DM + d0 + q4 * 8) = w;
    __syncthreads();
  }
  xcd_barrier(gbar);

  {
    const int wy = wid >> 2, wx = wid & 3;
    for (int u = vb; u < 192 * 11; u += G) {
      const int mt = u / 11, nt = u % 11;
      const bool swapped = !(nt >= 5 && nt < 9);
      const u16* At = xb + (size_t)mt * 256 * DM; const u16* Wt = w1t + (size_t)nt * 256 * DM;
      f32x16 acc[4][2];
#pragma unroll
      for (int a = 0; a < 4; ++a)
#pragma unroll
        for (int b = 0; b < 2; ++b) acc[a][b] = zero16();
      gemm_mainloop(lds, swapped ? Wt : At, swapped ? At : Wt, acc, tid);
      const int rowbase = mt * 256;
      int seqbase, S; seq_of_row(rowbase, seqbase, S);
      if (swapped) {
        if (nt < 2 || (nt == 2 && wy == 0)) {
          const bool isq = nt < 2;
          const float* nw = isq ? p.q_norm : p.k_norm;
          const float osc = isq ? QSCALE : 1.f;
#pragma unroll
          for (int ni = 0; ni < 2; ++ni) {
            const int token = rowbase + wx * 64 + ni * 32 + l32, pos = token - seqbase;
            const float ri = rinv[token];
#pragma unroll
            for (int hp = 0; hp < 2; ++hp) {
              float ss = 0.f;
#pragma unroll
              for (int mm = 0; mm < 2; ++mm)
#pragma unroll
                for (int r = 0; r < 16; ++r) { const float v = acc[hp * 2 + mm][ni][r] * ri; acc[hp * 2 + mm][ni][r] = v; ss += v * v; }
              ss += __shfl_xor(ss, 32);
              const float rn = rsqrtf(ss * (1.f / 64.f) + EPS);
              const int head = isq ? (nt * 4 + wy * 2 + hp) : hp;
#pragma unroll
              for (int mm = 0; mm < 2; ++mm) {
                const float posv = (float)((mm == 0) ? (pos >> 6) : (pos & 63));
#pragma unroll
                for (int r4 = 0; r4 < 4; ++r4) {
                  const int d = mm * 32 + 8 * r4 + 4 * hi;
                  const f32x4 wv = *(const f32x4*)(nw + d);
                  f32x4 cs;
                  { float pv2 = posv; asm volatile("" : "+v"(pv2));
                    const float jf = (float)(4 * r4 + 2 * hi);
                    const float rv0 = pv2 * (__builtin_amdgcn_exp2f(-0.8304820237218406f * jf) * 0.15915494309189535f), rv1 = pv2 * (__builtin_amdgcn_exp2f(-0.8304820237218406f * (jf + 1.f)) * 0.15915494309189535f);
                    cs.x = __builtin_amdgcn_cosf(rv0); cs.y = __builtin_amdgcn_sinf(rv0); cs.z = __builtin_amdgcn_cosf(rv1); cs.w = __builtin_amdgcn_sinf(rv1); }
                  const float x0 = acc[hp * 2 + mm][ni][r4 * 4 + 0] * rn * wv.x, x1 = acc[hp * 2 + mm][ni][r4 * 4 + 1] * rn * wv.y;
                  const float x2 = acc[hp * 2 + mm][ni][r4 * 4 + 2] * rn * wv.z, x3 = acc[hp * 2 + mm][ni][r4 * 4 + 3] * rn * wv.w;
                  const float o0 = (x0 * cs.x - x1 * cs.y) * osc, o1 = (x0 * cs.y + x1 * cs.x) * osc;
                  const float o2 = (x2 * cs.z - x3 * cs.w) * osc, o3 = (x2 * cs.w + x3 * cs.z) * osc;
                  u32x2 w; w.x = cvtpk(o0, o1); w.y = cvtpk(o2, o3);
                  if (isq) *(u32x2*)(qb + (size_t)token * 512 + head * 64 + d) = w;
                  else *(u32x2*)(kb + (size_t)token * 128 + head * 64 + d) = w;
                }
              }
            }
          }
        } else if (nt == 2) {
          u16* dst = vt + (size_t)seqbase * 128;
#pragma unroll
          for (int ni = 0; ni < 2; ++ni) {
            const int token = rowbase + wx * 64 + ni * 32 + l32, pos0 = token - seqbase;
            const int pos = (pos0 & ~12) | ((pos0 & 4) << 1) | ((pos0 & 8) >> 1);
            const float ri = rinv[token];
            u16* pv = dst + (size_t)(4 * hi) * S + pos;
#pragma unroll
            for (int mi = 0; mi < 4; ++mi)
#pragma unroll
              for (int r4 = 0; r4 < 4; ++r4) {
#pragma unroll
                for (int e = 0; e < 4; ++e) { *pv = (u16)(cvtpk(acc[mi][ni][r4 * 4 + e] * ri, 0.f) & 0xffffu); pv += S; asm volatile("" : "+v"(pv)); }
                pv += 4 * S; asm volatile("" : "+v"(pv));
              }
          }
        } else {
          u16* gdst = (nt < 5) ? ga : gf; const int cb = ((nt < 5) ? (nt - 3) : (nt - 9)) * 256 + wy * 128;
#pragma unroll
          for (int ni = 0; ni < 2; ++ni) {
            const int token = rowbase + wx * 64 + ni * 32 + l32; const float ri = rinv[token];
#pragma unroll
            for (int mi = 0; mi < 4; ++mi)
#pragma unroll
              for (int r4 = 0; r4 < 4; ++r4) {
                const float v0 = silu(acc[mi][ni][r4 * 4 + 0] * ri), v1 = silu(acc[mi][ni][r4 * 4 + 1] * ri), v2 = silu(acc[mi][ni][r4 * 4 + 2] * ri), v3 = silu(acc[mi][ni][r4 * 4 + 3] * ri);
                u32x2 w; w.x = cvtpk(v0, v1); w.y = cvtpk(v2, v3);
                stage_put(lds, wx * 64 + ni * 32 + l32, wy * 128 + mi * 32 + 8 * r4 + 4 * hi, w);
              }
          }
          stage_flush(lds, gdst + (size_t)rowbase * 512 + (cb - wy * 128), 512, wid, lane);
        }
      } else {
        u16* dst = zt + (size_t)seqbase * 1024 + (size_t)(nt - 5) * 256 * S;
#pragma unroll
        for (int mi = 0; mi < 4; ++mi)
#pragma unroll
          for (int r4 = 0; r4 < 4; ++r4) {
            const int token = rowbase + wy * 128 + mi * 32 + 8 * r4 + 4 * hi;
            const f32x4 ri = *(const f32x4*)(rinv + token);
#pragma unroll
            for (int ni = 0; ni < 2; ++ni) {
              const int ch = wx * 64 + ni * 32 + l32;
              u32x2 w; w.x = cvtpk(acc[mi][ni][r4 * 4 + 0] * ri.x, acc[mi][ni][r4 * 4 + 1] * ri.y); w.y = cvtpk(acc[mi][ni][r4 * 4 + 2] * ri.z, acc[mi][ni][r4 * 4 + 3] * ri.w);
              stage_put(lds, ch, wy * 128 + mi * 32 + 8 * r4 + 4 * hi, w);
            }
          }
        stage_flush(lds, dst + (rowbase - seqbase), S, wid, lane);
      }
    }
  }
  xcd_barrier(gbar);

  for (int u = gw; u < 6144; u += NW) {
    int seq, c, nb;
    if (u < 2048) { seq = 8 + (u >> 10); c = (u & 1023) >> 1; nb = u & 1; } else { const int v = u - 2048; seq = v >> 9; c = v & 511; nb = 0; }
    int seqbase, S; seq_info(seq, seqbase, S);
    const int KS = S >> 10;
    const u16* ftab = (S == 4096) ? f1a : f1b;
    const u16* zre = zt + (size_t)seqbase * 1024 + (size_t)c * S;
    const u16* zim = zre + (size_t)512 * S;
    f32x16 yr[2][2], yi[2][2];
#pragma unroll
    for (int a = 0; a < 2; ++a)
#pragma unroll
      for (int b = 0; b < 2; ++b) { yr[a][b] = zero16(); yi[a][b] = zero16(); }
    bf16x8 idf[2];
#pragma unroll
    for (int h2 = 0; h2 < 2; ++h2) { u32x4 t;
      const int b = l32 - 16 * h2 - 8 * hi;
      t.x = (b == 0 ? 0x3f80u : 0u) | (b == 1 ? 0x3f800000u : 0u); t.y = (b == 2 ? 0x3f80u : 0u) | (b == 3 ? 0x3f800000u : 0u);
      t.z = (b == 4 ? 0x3f80u : 0u) | (b == 5 ? 0x3f800000u : 0u); t.w = (b == 6 ? 0x3f80u : 0u) | (b == 7 ? 0x3f800000u : 0u);
      idf[h2] = __builtin_bit_cast(bf16x8, t); }
    for (int mt = 0; mt < (KS >> 1); ++mt) {
      bf16x8 zr[2][2], zi[2][2];
      {
        const u16* pr = zre + (size_t)(mt * 32 + l32) * 64 + 8 * hi;
        const u16* pi = zim + (size_t)(mt * 32 + l32) * 64 + 8 * hi;
        bf16x8 ar[4], ai[4];
#pragma unroll
        for (int kk = 0; kk < 4; ++kk) { ar[kk] = *(const bf16x8*)(pr + kk * 16); ai[kk] = *(const bf16x8*)(pi + kk * 16); }
#pragma unroll
        for (int nt = 0; nt < 2; ++nt) {
          f32x16 dr = __builtin_amdgcn_mfma_f32_32x32x16_bf16(ar[2 * nt], idf[0], zero16(), 0, 0, 0);
          dr = __builtin_amdgcn_mfma_f32_32x32x16_bf16(ar[2 * nt + 1], idf[1], dr, 0, 0, 0);
          f32x16 di = __builtin_amdgcn_mfma_f32_32x32x16_bf16(ai[2 * nt], idf[0], zero16(), 0, 0, 0);
          di = __builtin_amdgcn_mfma_f32_32x32x16_bf16(ai[2 * nt + 1], idf[1], di, 0, 0, 0);
#pragma unroll
          for (int k2 = 0; k2 < 2; ++k2) {
            u32x4 a, b; a.x = cvtpk(dr[k2 * 8 + 0], dr[k2 * 8 + 1]); a.y = cvtpk(dr[k2 * 8 + 2], dr[k2 * 8 + 3]); a.z = cvtpk(dr[k2 * 8 + 4], dr[k2 * 8 + 5]); a.w = cvtpk(dr[k2 * 8 + 6], dr[k2 * 8 + 7]);
            b.x = cvtpk(di[k2 * 8 + 0], di[k2 * 8 + 1]); b.y = cvtpk(di[k2 * 8 + 2], di[k2 * 8 + 3]); b.z = cvtpk(di[k2 * 8 + 4], di[k2 * 8 + 5]); b.w = cvtpk(di[k2 * 8 + 6], di[k2 * 8 + 7]);
            zr[nt][k2] = __builtin_bit_cast(bf16x8, a); zi[nt][k2] = __builtin_bit_cast(bf16x8, b);
          }
        }
      }
#pragma unroll
      for (int k2 = 0; k2 < 2; ++k2) {
        const int ks = mt * 2 + k2;
        bf16x8 fc[2], fs[2], fn[2];
#pragma unroll
        for (int ni = 0; ni < 2; ++ni) {
          const size_t fo = ((size_t)(((nb * KS + ks) * 2 + ni) * 2) * 64 + lane) * 8;
          fc[ni] = *(const bf16x8*)(ftab + fo); fs[ni] = *(const bf16x8*)(ftab + fo + 512);
          u32x4 t = __builtin_bit_cast(u32x4, fs[ni]); t.x ^= 0x80008000u; t.y ^= 0x80008000u; t.z ^= 0x80008000u; t.w ^= 0x80008000u; fn[ni] = __builtin_bit_cast(bf16x8, t);
        }
#pragma unroll
        for (int mi = 0; mi < 2; ++mi)
#pragma unroll
          for (int ni = 0; ni < 2; ++ni) {
            yr[mi][ni] = __builtin_amdgcn_mfma_f32_32x32x16_bf16(zr[mi][k2], fc[ni], yr[mi][ni], 0, 0, 0);
            yr[mi][ni] = __builtin_amdgcn_mfma_f32_32x32x16_bf16(zi[mi][k2], fs[ni], yr[mi][ni], 0, 0, 0);
            yi[mi][ni] = __builtin_amdgcn_mfma_f32_32x32x16_bf16(zi[mi][k2], fc[ni], yi[mi][ni], 0, 0, 0);
            yi[mi][ni] = __builtin_amdgcn_mfma_f32_32x32x16_bf16(zr[mi][k2], fn[ni], yi[mi][ni], 0, 0, 0);
          }
      }
    }
    const int tsh = (S == 4096) ? 1 : 0;
    u16* ybase = y1 + (size_t)seqbase * 1024;
    LAS unsigned char* wl = lds + wid * 16384;
#pragma unroll
    for (int ni = 0; ni < 2; ++ni) {
      const int sb = nb * 64 + ni * 32 + l32;
#pragma unroll
      for (int mi = 0; mi < 2; ++mi)
#pragma unroll
        for (int r4 = 0; r4 < 4; ++r4) {
          const int tl0 = mi * 32 + 8 * r4 + 4 * hi;
          float orr[4], oii[4];
#pragma unroll
          for (int e = 0; e < 4; ++e) {
            const int idx = ((sb * (tl0 + e)) << tsh) & 8191;
            const float rev = (float)idx * (1.f / 8192.f);
            const float tc = __builtin_amdgcn_cosf(rev), ts = __builtin_amdgcn_sinf(rev);
            const float a = yr[mi][ni][r4 * 4 + e], b = yi[mi][ni][r4 * 4 + e];
            orr[e] = a * tc + b * ts; oii[e] = b * tc - a * ts;
          }
          const int rl = ni * 32 + l32;
          u32x2 w; w.x = cvtpk(orr[0], orr[1]); w.y = cvtpk(orr[2], orr[3]); *(LAS u32x2*)(wl + rl * 256 + ((((tl0 >> 2)) ^ (rl & 31)) << 3)) = w;
          w.x = cvtpk(oii[0], oii[1]); w.y = cvtpk(oii[2], oii[3]); *(LAS u32x2*)(wl + rl * 256 + (((16 + (tl0 >> 2)) ^ (rl & 31)) << 3)) = w;
        }
    }
    {
      u16* yblk = ybase + ((size_t)c * (S >> 6) + nb * 64) * 128;
      const int cc = lane & 15, rq = lane >> 4;
#pragma unroll 4
      for (int rd = 0; rd < 16; ++rd) {
        const int r = rd * 4 + rq;
        u32x4 v = *(const LAS u32x4*)(wl + r * 256 + ((cc ^ ((r & 31) >> 1)) << 4));
        if (r & 1) { u32x4 t; t.x = v.z; t.y = v.w; t.z = v.x; t.w = v.y; v = t; }
        __builtin_nontemporal_store(v, (u32x4*)(yblk + (size_t)r * 128 + cc * 8));
      }
    }
  }
  xcd_barrier(gbar);

  float att_B; bool att_online;
  { float wq = fabsf(p.q_norm[lane]), wk = fabsf(p.k_norm[lane]);
#pragma unroll
    for (int o = 1; o < 64; o <<= 1) { wq = fmaxf(wq, __shfl_xor(wq, o)); wk = fmaxf(wk, __shfl_xor(wk, o)); }
    att_B = __uint_as_float(__builtin_amdgcn_readfirstlane(__float_as_uint(64.f * QSCALE * wq * wk))); att_online = !(att_B < 40.f); }
  for (int u = vb; u < 3072; u += G) {
    if (u < 1536) {
      int seq, qblk, h;
      if (u < 512) { seq = 8 + (u >> 8); const int rem = u & 255; qblk = (rem >> 2) & 31; h = (rem >> 7) * 4 + (rem & 3); } else { const int v = u - 512; seq = v >> 7; const int rem = v & 127; qblk = (rem >> 2) & 15; h = (rem >> 6) * 4 + (rem & 3); }
      int seqbase, S; seq_info(seq, seqbase, S);
      const int kvh = h >> 2, NTL = S >> 6;
      const int qtoken = seqbase + qblk * 256 + wid * 32 + l32;
      bf16x8 qf[4];
#pragma unroll
      for (int ks = 0; ks < 4; ++ks) qf[ks] = *(const bf16x8*)(qb + (size_t)qtoken * 512 + h * 64 + ks * 16 + hi * 8);
      const int c = tid & 7, r0 = tid >> 3;
      const u16* kp = kb + (size_t)(seqbase + r0) * 128 + kvh * 64 + c * 8;
      const u16* vp = vt + (size_t)seqbase * 128 + (size_t)(kvh * 64 + r0) * S + c * 8;
      const unsigned woff = r0 * 128 + ((c ^ ((r0 >> 1) & 7)) << 4);
      const int sw = (l32 >> 1) & 7;
      u32x4 kr = *(const u32x4*)kp, vr = *(const u32x4*)vp;
      *(LAS u32x4*)(lds + woff) = kr; *(LAS u32x4*)(lds + 8192 + woff) = vr;
      __syncthreads();
      f32x16 o[2]; o[0] = zero16(); o[1] = zero16();
      float m = 0.f, lsum = 0.f;
      for (int kt = 0; kt < NTL; ++kt) {
        const unsigned bo = (kt & 1) * 16384;
        if (kt + 1 < NTL) { kr = *(const u32x4*)(kp + (size_t)(kt + 1) * 64 * 128); vr = *(const u32x4*)(vp + (size_t)(kt + 1) * 64); }
        f32x16 st[2];
        bf16x8 kf[8];
#pragma unroll
        for (int ks = 0; ks < 4; ++ks) {
          const unsigned co = (unsigned)(((ks * 2 + hi) ^ sw) << 4);
#pragma unroll
          for (int mt = 0; mt < 2; ++mt) kf[ks * 2 + mt] = *(const LAS bf16x8*)(lds + bo + (mt * 32 + l32) * 128 + co);
        }
        __builtin_amdgcn_sched_barrier(0);
#pragma unroll
        for (int ks = 0; ks < 4; ++ks)
#pragma unroll
          for (int mt = 0; mt < 2; ++mt) {
            if (ks == 0) st[mt] = __builtin_amdgcn_mfma_f32_32x32x16_bf16(kf[ks * 2 + mt], qf[ks], zero16(), 0, 0, 0);
            else st[mt] = __builtin_amdgcn_mfma_f32_32x32x16_bf16(kf[ks * 2 + mt], qf[ks], st[mt], 0, 0, 0);
          }
        if (att_online) {
#pragma unroll
        for (int r = 0; r < 16; ++r) { st[0][r] -= m; st[1][r] -= m; }
        float ra = __builtin_fmaxf(__builtin_fmaxf(st[0][0], st[0][1]), st[0][2]), rb = __builtin_fmaxf(__builtin_fmaxf(st[1][0], st[1][1]), st[1][2]);
#pragma unroll
        for (int r = 3; r < 15; r += 2) { ra = __builtin_fmaxf(__builtin_fmaxf(ra, st[0][r]), st[0][r + 1]); rb = __builtin_fmaxf(__builtin_fmaxf(rb, st[1][r]), st[1][r + 1]); }
        float rm = __builtin_fmaxf(__builtin_fmaxf(ra, rb), __builtin_fmaxf(st[0][15], st[1][15]));
        { const auto rr = __builtin_amdgcn_permlane32_swap(__float_as_uint(rm), __float_as_uint(rm), false, false); rm = __builtin_fmaxf(__uint_as_float(rr[0]), __uint_as_float(rr[1])); }
        if (kt == 0 || __any(rm > 8.f)) {
          const float dl = (kt == 0) ? rm : fmaxf(rm, 0.f);
          m += dl;
          const float f = __builtin_amdgcn_exp2f(-dl);
          lsum *= f;
#pragma unroll
          for (int r = 0; r < 16; ++r) { st[0][r] -= dl; st[1][r] -= dl; o[0][r] *= f; o[1][r] *= f; }
        }
        }
        f32x2 pa = {0.f, 0.f}, pb = {0.f, 0.f};
#pragma unroll
        for (int r = 0; r < 16; r += 2) { const float e0 = __builtin_amdgcn_exp2f(st[0][r]); st[0][r] = e0; const float e1 = __builtin_amdgcn_exp2f(st[1][r]); st[1][r] = e1;
          const float e2 = __builtin_amdgcn_exp2f(st[0][r + 1]); st[0][r + 1] = e2; const float e3 = __builtin_amdgcn_exp2f(st[1][r + 1]); st[1][r + 1] = e3;
          f32x2 t0 = {e0, e2}, t1 = {e1, e3}; pa += t0; pb += t1; }
        pa += pb; lsum += pa.x + pa.y;
#pragma unroll
        for (int kk = 0; kk < 4; ++kk) {
          const int mt = kk >> 1, hb = (kk & 1) * 8;
          u32x4 pw; pw.x = cvtpk(st[mt][hb + 0], st[mt][hb + 1]); pw.y = cvtpk(st[mt][hb + 2], st[mt][hb + 3]); pw.z = cvtpk(st[mt][hb + 4], st[mt][hb + 5]); pw.w = cvtpk(st[mt][hb + 6], st[mt][hb + 7]);
          const bf16x8 pf = __builtin_bit_cast(bf16x8, pw);
          const unsigned cv = (unsigned)(((kk * 2 + hi) ^ sw) << 4);
#pragma unroll
          for (int dt = 0; dt < 2; ++dt) {
            const bf16x8 vf = *(const LAS bf16x8*)(lds + bo + 8192 + (dt * 32 + l32) * 128 + cv);
            o[dt] = __builtin_amdgcn_mfma_f32_32x32x16_bf16(vf, pf, o[dt], 0, 0, 0);
          }
        }
        if (kt + 1 < NTL) { const unsigned bn = ((kt + 1) & 1) * 16384; *(LAS u32x4*)(lds + bn + woff) = kr; *(LAS u32x4*)(lds + bn + 8192 + woff) = vr; }
        __syncthreads();
      }
      lsum += __shfl_xor(lsum, 32);
      const float inv = 1.f / lsum;
      {
        LAS unsigned char* wl = lds + 65536 + wid * 4096;
#pragma unroll
        for (int dt = 0; dt < 2; ++dt)
#pragma unroll
          for (int r4 = 0; r4 < 4; ++r4) {
            const int q = (dt * 32 + 8 * r4 + 4 * hi) >> 2;
            u32x2 w; w.x = cvtpk(o[dt][r4 * 4 + 0] * inv, o[dt][r4 * 4 + 1] * inv); w.y = cvtpk(o[dt][r4 * 4 + 2] * inv, o[dt][r4 * 4 + 3] * inv);
            *(LAS u32x2*)(wl + l32 * 128 + ((q ^ (l32 & 15)) << 3)) = w;
          }
        const int cc = lane & 7, rq = lane >> 3;
        const int tok0 = seqbase + qblk * 256 + wid * 32;
#pragma unroll
        for (int rd = 0; rd < 4; ++rd) {
          const int r = rd * 8 + rq;
          u32x4 v = *(const LAS u32x4*)(wl + r * 128 + ((cc ^ ((r & 15) >> 1)) << 4));
          if (r & 1) { u32x4 t; t.x = v.z; t.y = v.w; t.z = v.x; t.w = v.y; v = t; }
          const u32x4 g = *(const u32x4*)(ga + (size_t)(tok0 + r) * 512 + h * 64 + cc * 8);
          u32x4 w;
          w.x = cvtpk(__uint_as_float(v.x << 16) * __uint_as_float(g.x << 16), __uint_as_float(v.x & 0xffff0000u) * __uint_as_float(g.x & 0xffff0000u));
          w.y = cvtpk(__uint_as_float(v.y << 16) * __uint_as_float(g.y << 16), __uint_as_float(v.y & 0xffff0000u) * __uint_as_float(g.y & 0xffff0000u));
          w.z = cvtpk(__uint_as_float(v.z << 16) * __uint_as_float(g.z << 16), __uint_as_float(v.z & 0xffff0000u) * __uint_as_float(g.z & 0xffff0000u));
          w.w = cvtpk(__uint_as_float(v.w << 16) * __uint_as_float(g.w << 16), __uint_as_float(v.w & 0xffff0000u) * __uint_as_float(g.w & 0xffff0000u));
          *(u32x4*)(yb + (size_t)(tok0 + r) * 1024 + h * 64 + cc * 8) = w;
        }
      }
    } else {
      const int v = u - 1536; int seq, sb, gp;
      if (v < 512) { seq = 8 + (v >> 8); const int rem = v & 255; sb = rem >> 1; gp = rem & 1; } else { const int w = v - 512; seq = w >> 7; const int rem = w & 127; sb = rem >> 1; gp = rem & 1; }
      int seqbase, S; seq_info(seq, seqbase, S);
      const int H = S >> 6;
      const int cch = gp * 256 + wid * 32 + l32;
      const u16* arow = y1 + (size_t)seqbase * 1024 + ((size_t)cch * H + sb) * 128 + 8 * hi;
      f32x16 acc[2]; acc[0] = zero16(); acc[1] = zero16();
#pragma unroll
      for (int ks = 0; ks < 8; ++ks) {
        const bf16x8 af = *(const bf16x8*)(arow + ks * 16);
#pragma unroll
        for (int nt = 0; nt < 2; ++nt) {
          const bf16x8 bf = *(const bf16x8*)(f2t + ((size_t)(ks * 2 + nt) * 64 + lane) * 8);
          acc[nt] = __builtin_amdgcn_mfma_f32_32x32x16_bf16(af, bf, acc[nt], 0, 0, 0);
        }
      }
      const float nrm = (S == 4096) ? (1.f / 64.f) : 0.011048543456039806f;
      {
        LAS unsigned char* wl = lds + 65536 + wid * 4096;
#pragma unroll
        for (int nt = 0; nt < 2; ++nt) {
          const int rl = nt * 32 + l32;
#pragma unroll
          for (int r4 = 0; r4 < 4; ++r4) {
            const f32x4 bias = *(const f32x4*)(p.b_f + gp * 256 + wid * 32 + 8 * r4 + 4 * hi);
            u32x2 w; w.x = cvtpk(acc[nt][r4 * 4 + 0] * nrm + bias.x, acc[nt][r4 * 4 + 1] * nrm + bias.y); w.y = cvtpk(acc[nt][r4 * 4 + 2] * nrm + bias.z, acc[nt][r4 * 4 + 3] * nrm + bias.w);
            *(LAS u32x2*)(wl + rl * 64 + ((((8 * r4 + 4 * hi) >> 2) ^ (rl & 7)) << 3)) = w;
          }
        }
        const int cc = lane & 3, rq = lane >> 2;
#pragma unroll
        for (int rd = 0; rd < 4; ++rd) {
          const int r = rd * 16 + rq;
          const int token = seqbase + r * H + sb;
          u32x4 v = *(const LAS u32x4*)(wl + r * 64 + ((cc ^ ((r & 7) >> 1)) << 4));
          if (r & 1) { u32x4 t; t.x = v.z; t.y = v.w; t.z = v.x; t.w = v.y; v = t; }
          const int ch = gp * 256 + wid * 32 + cc * 8;
          const u32x4 g = *(const u32x4*)(gf + (size_t)token * 512 + ch);
          u32x4 w;
          w.x = cvtpk(__uint_as_float(v.x << 16) * __uint_as_float(g.x << 16), __uint_as_float(v.x & 0xffff0000u) * __uint_as_float(g.x & 0xffff0000u));
          w.y = cvtpk(__uint_as_float(v.y << 16) * __uint_as_float(g.y << 16), __uint_as_float(v.y & 0xffff0000u) * __uint_as_float(g.y & 0xffff0000u));
          w.z = cvtpk(__uint_as_float(v.z << 16) * __uint_as_float(g.z << 16), __uint_as_float(v.z & 0xffff0000u) * __uint_as_float(g.z & 0xffff0000u));
          w.w = cvtpk(__uint_as_float(v.w << 16) * __uint_as_float(g.w << 16), __uint_as_float(v.w & 0xffff0000u) * __uint_as_float(g.w & 0xffff0000u));
          *(u32x4*)(yb + (size_t)token * 1024 + 512 + ch) = w;
        }
      }
    }
  }
  xcd_barrier(gbar);

  {
    const int wy = wid >> 2, wx = wid & 3;
    for (int u = vb; u < 192 * 4; u += G) {
      const int mt = u >> 2, nt = u & 3;
      f32x16 acc[4][2];
#pragma unroll
      for (int a = 0; a < 4; ++a)
#pragma unroll
        for (int b = 0; b < 2; ++b) acc[a][b] = zero16();
      gemm_mainloop(lds, wot + (size_t)nt * 256 * DM, yb + (size_t)mt * 256 * DM, acc, tid);
#pragma unroll
      for (int ni = 0; ni < 2; ++ni) {
        const int token = mt * 256 + wx * 64 + ni * 32 + l32;
        u16* yrow = yw + (size_t)token * DM;
#pragma unroll
        for (int mi = 0; mi < 4; ++mi)
#pragma unroll
          for (int r4 = 0; r4 < 4; ++r4) {
            const int col = nt * 256 + wy * 128 + mi * 32 + 8 * r4 + 4 * hi;
            u32x2 w; w.x = cvtpk(acc[mi][ni][r4 * 4 + 0], acc[mi][ni][r4 * 4 + 1]); w.y = cvtpk(acc[mi][ni][r4 * 4 + 2], acc[mi][ni][r4 * 4 + 3]);
            stage_put(lds, wx * 64 + ni * 32 + l32, wy * 128 + mi * 32 + 8 * r4 + 4 * hi, w);
          }
      }
      stage_flush(lds, yw + (size_t)mt * 256 * DM + nt * 256, DM, wid, lane);
    }
  }
  xcd_barrier(gbar);

  for (int row = gw; row < NTOK; row += NW) {
    const float* xr = (row < NPROMPT) ? p.x_prompt + (size_t)row * DM : p.x_sample + (size_t)(row - NPROMPT) * DM;
    const u32x2* yr = (const u32x2*)(yw + (size_t)row * DM);
    f32x4 v[4]; float ss = 0.f;
#pragma unroll
    for (int j = 0; j < 4; ++j) {
      const f32x4 xv = __builtin_nontemporal_load((const f32x4*)xr + lane + 64 * j); const u32x2 y = yr[lane + 64 * j];
      v[j].x = xv.x + __uint_as_float(y.x << 16); v[j].y = xv.y + __uint_as_float(y.x & 0xffff0000u); v[j].z = xv.z + __uint_as_float(y.y << 16); v[j].w = xv.w + __uint_as_float(y.y & 0xffff0000u);
      ss += v[j].x * v[j].x + v[j].y * v[j].y + v[j].z * v[j].z + v[j].w * v[j].w;
    }
#pragma unroll
    for (int o = 1; o < 64; o <<= 1) ss += __shfl_xor(ss, o);
    const float rn = rsqrtf(ss * (1.f / DM) + EPS);
    f32x4* orow = (f32x4*)(p.out + (size_t)row * DM);
#pragma unroll
    for (int j = 0; j < 4; ++j) {
      const f32x4 w = ((const f32x4*)p.final_norm)[lane + 64 * j]; f32x4 z = v[j];
      z.x *= rn * w.x; z.y *= rn * w.y; z.z *= rn * w.z; z.w *= rn * w.w; orow[lane + 64 * j] = z;
    }
  }
}

extern "C" void kernel_launch(void* const* d_in, const int* in_sizes, int n_in, void* d_out, int out_size, void* d_ws, size_t ws_size, hipStream_t stream) {
  static int grid_blocks = 0;
  if (!grid_blocks) {
    int dev = 0, cus = 0, per_cu = 0;
    hipGetDevice(&dev);
    hipDeviceGetAttribute(&cus, hipDeviceAttributeMultiprocessorCount, dev);
    hipFuncSetAttribute((const void*)fwd_kernel, hipFuncAttributeMaxDynamicSharedMemorySize, LDS_BYTES);
    hipOccupancyMaxActiveBlocksPerMultiprocessor(&per_cu, (const void*)fwd_kernel, NTHR, LDS_BYTES);
    if (per_cu < 1) per_cu = 1;
    if (per_cu > 1) per_cu = 1;
    grid_blocks = cus * per_cu;
  }
  hipMemsetAsync((char*)d_ws + OFF_BAR, 0, 16384, stream);
  Params p{};
  p.x_prompt = (const float*)d_in[0]; p.x_sample = (const float*)d_in[1]; p.ln_w = (const float*)d_in[2]; p.w_in = (const float*)d_in[3];
  p.q_norm = (const float*)d_in[4]; p.k_norm = (const float*)d_in[5]; p.w_f = (const float*)d_in[6]; p.b_f = (const float*)d_in[7];
  p.w_out = (const float*)d_in[8]; p.final_norm = (const float*)d_in[9];
  p.out = (float*)d_out; p.ws = (unsigned char*)d_ws;
  void* args[] = {&p};
  hipError_t e = hipLaunchCooperativeKernel((const void*)fwd_kernel, dim3(grid_blocks), dim3(NTHR), args, LDS_BYTES, stream);
  if (e != hipSuccess) fprintf(stderr, "cooperative launch failed: %s (grid %d)\n", hipGetErrorString(e), grid_blocks);
}
```

```cpp
#include <hip/hip_runtime.h>
#include <hip/hip_cooperative_groups.h>
#include <cstdio>
#include <cstdint>
namespace cg = cooperative_groups;

typedef unsigned short u16;
typedef short bf16x8 __attribute__((ext_vector_type(8)));
typedef float f32x16 __attribute__((ext_vector_type(16)));
typedef float f32x4 __attribute__((ext_vector_type(4)));
typedef float f32x2 __attribute__((ext_vector_type(2)));
typedef unsigned u32x4 __attribute__((ext_vector_type(4)));
typedef unsigned u32x2 __attribute__((ext_vector_type(2)));
typedef __bf16 bf16x2_t __attribute__((ext_vector_type(2)));
#define LAS __attribute__((address_space(3)))

constexpr int DM = 1024, NTOK = 49152, NPROMPT = 32768, N1 = 2816, WIN_LD = 2304;
constexpr float EPS = 1e-6f;
constexpr float QSCALE = 0.125f * 1.4426950408889634f;
constexpr size_t MiB = 1u << 20, KiB = 1u << 10;
constexpr size_t OFF_XB = 0;
constexpr size_t OFF_RINV = 96 * MiB;
constexpr size_t OFF_ROWSS = 96 * MiB + 256 * KiB;
constexpr size_t OFF_ROPE = 96 * MiB + 512 * KiB;
constexpr size_t OFF_TW = 96 * MiB + 576 * KiB;
constexpr size_t OFF_F1A = 96 * MiB + 640 * KiB;
constexpr size_t OFF_F1B = 96 * MiB + 704 * KiB;
constexpr size_t OFF_F2 = 96 * MiB + 768 * KiB;
constexpr size_t OFF_MF = 97 * MiB;
constexpr size_t OFF_W1T = 98 * MiB;
constexpr size_t OFF_WOT = 104 * MiB;
constexpr size_t OFF_Q = 112 * MiB;
constexpr size_t OFF_K = 160 * MiB;
constexpr size_t OFF_VT = 172 * MiB;
constexpr size_t OFF_GA = 184 * MiB;
constexpr size_t OFF_GF = 232 * MiB;
constexpr size_t OFF_YB = 280 * MiB;
constexpr size_t OFF_BAR = 96 * MiB + 832 * KiB;
constexpr int LDS_MAIN = 131072, LDS_BYTES = LDS_MAIN + 64;
constexpr int NTHR = 512, NWAVE = 8;

struct Params {
  const float *x_prompt, *x_sample, *ln_w, *w_in, *q_norm, *k_norm, *w_f, *b_f, *w_out, *final_norm;
  float* out; unsigned char* ws;
};

__device__ __forceinline__ unsigned cvtpk(float lo, float hi) { f32x2 v = {lo, hi}; bf16x2_t b = __builtin_convertvector(v, bf16x2_t); return __builtin_bit_cast(unsigned, b); }
__device__ __forceinline__ float bf2f(unsigned short h) { return __uint_as_float(((unsigned)h) << 16); }
__device__ __forceinline__ float silu(float v) { return v * __builtin_amdgcn_rcpf(1.f + __builtin_amdgcn_exp2f(-1.4426950408889634f * v)); }
__device__ __forceinline__ void seq_info(int seq, int& seqbase, int& S) { if (seq < 8) { seqbase = seq * 4096; S = 4096; } else { seqbase = NPROMPT + (seq - 8) * 8192; S = 8192; } }
__device__ __forceinline__ void seq_of_row(int row, int& seqbase, int& S) { if (row < NPROMPT) { seqbase = row & ~4095; S = 4096; } else { seqbase = NPROMPT + ((row - NPROMPT) & ~8191); S = 8192; } }
__device__ __forceinline__ f32x16 zero16() { f32x16 z; for (int i = 0; i < 16; ++i) z[i] = 0.f; return z; }


#define XB_TMO      128
#define XB_XCNT(j)  (256  + 64 * (j))
#define XB_XSUB(j)  (1280 + 64 * (j))
#define XB_XGEN(j)  (2304 + 64 * (j))
#define XB_TOP      3328
#define XB_TOPGEN   3392
#define XCD_BAR_WORDS 3456
#define XB_SPIN_CAP (1u << 18)
__device__ __forceinline__ unsigned xb_ld(unsigned* p)              { return __hip_atomic_load(p, __ATOMIC_RELAXED, __HIP_MEMORY_SCOPE_AGENT); }
__device__ __forceinline__ unsigned xb_add(unsigned* p, unsigned v) { return __hip_atomic_fetch_add(p, v, __ATOMIC_RELAXED, __HIP_MEMORY_SCOPE_AGENT); }
__device__ __forceinline__ unsigned xb_xcc_id() { return (unsigned)__builtin_amdgcn_s_getreg((3 << 11) | 20) & 0xFu; }
#define XB_SPIN(cond, bar) do { unsigned _sp = 0; while (cond) { __builtin_amdgcn_s_sleep(1); \
    if ((++_sp & 255u) == 0u) { if (xb_ld(&(bar)[XB_TMO])) break; if (_sp > XB_SPIN_CAP) { atomicAdd(&(bar)[XB_TMO], 1u); break; } } } } while (0)
struct XcdBarrier { unsigned* bar; unsigned x; volatile LAS unsigned* st; };
__device__ __forceinline__ XcdBarrier xcd_barrier_post(unsigned* bar, volatile LAS unsigned* st) {
  XcdBarrier b; b.bar = bar; b.x = xb_xcc_id(); b.st = st;
  if (threadIdx.x == 0) (void)xb_add(&bar[XB_XCNT(b.x)], 1u);
  return b;
}
__device__ __forceinline__ void xcd_barrier_complete(unsigned* bar, unsigned x, unsigned& nloc, unsigned& nx) {
  const unsigned G = gridDim.x * gridDim.y * gridDim.z;
  unsigned sum, cnt, mine, sp = 0u;
  for (;;) {
    sum = 0u; cnt = 0u; mine = 0u;
#pragma unroll
    for (unsigned j = 0; j < 16; ++j) { const unsigned c = xb_ld(&bar[XB_XCNT(j)]); sum += c; cnt += (c > 0u) ? 1u : 0u; mine = (j == x) ? c : mine; }
    if (sum == G) break;
    __builtin_amdgcn_s_sleep(1);
    if ((++sp & 255u) == 0u) { if (xb_ld(&bar[XB_TMO])) break; if (sp > XB_SPIN_CAP) { atomicAdd(&bar[XB_TMO], 1u); break; } }
  }
  nloc = mine > 0u ? mine : 1u; nx = cnt > 0u ? cnt : 1u;
}
__device__ __forceinline__ void xcd_barrier(const XcdBarrier& b) {
  asm volatile("s_waitcnt vmcnt(0)" ::: "memory");
  __syncthreads();
  if (threadIdx.x == 0) {
    unsigned* bar = b.bar;
    __builtin_amdgcn_s_waitcnt(0);
    unsigned nloc = b.st[0], nx = b.st[1];
    if (nloc == 0u) { xcd_barrier_complete(bar, b.x, nloc, nx); b.st[0] = nloc; b.st[1] = nx; }
    const unsigned old = xb_add(&bar[XB_XSUB(b.x)], 1u);
    const unsigned gen = old / nloc;
    if (old + 1u == (gen + 1u) * nloc) {
      __builtin_amdgcn_fence(__ATOMIC_RELEASE, "agent");
      asm volatile("s_waitcnt vmcnt(0)" ::: "memory");
      const unsigned og = xb_add(&bar[XB_TOP], 1u);
      const unsigned tg = og / nx;
      if (og + 1u == (tg + 1u) * nx) xb_add(&bar[XB_TOPGEN], 1u);
      else XB_SPIN(xb_ld(&bar[XB_TOPGEN]) == tg, bar);
      __builtin_amdgcn_fence(__ATOMIC_ACQUIRE, "agent");
      xb_add(&bar[XB_XGEN(b.x)], 1u);
      asm volatile("s_waitcnt vmcnt(0)" ::: "memory");
    } else {
      XB_SPIN(xb_ld(&bar[XB_XGEN(b.x)]) == gen, bar);
      __builtin_amdgcn_fence(__ATOMIC_ACQUIRE, "agent");
      asm volatile("s_waitcnt vmcnt(0)" ::: "memory");
    }
  }
  __syncthreads();
}

__device__ __forceinline__ void gemm_mainloop(LAS unsigned char* lds, const u16* Xg, const u16* Yg, f32x16 (&acc)[4][2], int tid) {
  const int lane = tid & 63, wid = __builtin_amdgcn_readfirstlane(tid >> 6), wy = wid >> 2, wx = wid & 3, l32 = lane & 31, hi = lane >> 5;
  const int drow = wid * 16 + (lane >> 2), dch = (lane & 3) ^ ((drow >> 2) & 3);
  const u16* xp = Xg + (size_t)drow * 1024 + dch * 8;
  const u16* yp = Yg + (size_t)drow * 1024 + dch * 8;
  const int sw = (l32 >> 2) & 3;
  const unsigned xbase = (wy * 128 + l32) * 64, ybase = 16384 + (wx * 64 + l32) * 64;
  const unsigned ldsw = (unsigned)wid * 1024u;
#define GEMM_DMA(j_) do { const unsigned so_ = (unsigned)(((j_) & 3) * 32768); _Pragma("unroll") for (int i_ = 0; i_ < 2; ++i_) { \
    __builtin_amdgcn_global_load_lds((const unsigned*)(xp + (size_t)i_ * 128 * 1024 + (j_) * 32), (LAS unsigned*)(lds + so_ + ldsw + i_ * 8192), 16, 0, 0); \
    __builtin_amdgcn_global_load_lds((const unsigned*)(yp + (size_t)i_ * 128 * 1024 + (j_) * 32), (LAS unsigned*)(lds + so_ + 16384 + ldsw + i_ * 8192), 16, 0, 0); } } while (0)
  GEMM_DMA(0); GEMM_DMA(1); GEMM_DMA(2);
#pragma unroll 4
  for (int j = 0; j < 32; ++j) {
    const unsigned bo = (unsigned)((j & 3) * 32768);
    if (j < 30) asm volatile("s_waitcnt vmcnt(8) lgkmcnt(0)" ::: "memory");
    else if (j == 30) asm volatile("s_waitcnt vmcnt(4) lgkmcnt(0)" ::: "memory");
    else asm volatile("s_waitcnt vmcnt(0) lgkmcnt(0)" ::: "memory");
    __builtin_amdgcn_s_barrier();
    asm volatile("" ::: "memory");
    if (j + 3 < 32) GEMM_DMA(j + 3);
#pragma unroll
    for (int ks = 0; ks < 2; ++ks) {
      const unsigned co = (unsigned)(((ks * 2 + hi) ^ sw) << 4);
      bf16x8 xf[4], yf[2];
#pragma unroll
      for (int ni = 0; ni < 2; ++ni) yf[ni] = *(const LAS bf16x8*)(lds + bo + ybase + ni * 2048 + co);
#pragma unroll
      for (int mi = 0; mi < 4; ++mi) xf[mi] = *(const LAS bf16x8*)(lds + bo + xbase + mi * 2048 + co);
#pragma unroll
      for (int mi = 0; mi < 4; ++mi)
#pragma unroll
        for (int ni = 0; ni < 2; ++ni) acc[mi][ni] = __builtin_amdgcn_mfma_f32_32x32x16_bf16(xf[mi], yf[ni], acc[mi][ni], 0, 0, 0);
    }
  }
#undef GEMM_DMA
  asm volatile("s_waitcnt lgkmcnt(0)" ::: "memory");
  __builtin_amdgcn_s_barrier();
  asm volatile("" ::: "memory");
}


__device__ __forceinline__ void stage_put(LAS unsigned char* lds, int row, int col, u32x2 w) { *(LAS u32x2*)(lds + row * 512 + (((col >> 2) ^ (row & 63)) << 3)) = w; }
template <bool NT = true> __device__ __forceinline__ void stage_flush(LAS unsigned char* lds, u16* dst, int ld, int wid, int lane) {
  __syncthreads();
  const int c = lane & 31, hh = lane >> 5;
#pragma unroll 2
  for (int rd = 0; rd < 16; ++rd) {
    const int r = rd * 16 + wid * 2 + hh;
    u32x4 v = *(const LAS u32x4*)(lds + r * 512 + ((c ^ ((r & 63) >> 1)) << 4));
    if (r & 1) { u32x4 t; t.x = v.z; t.y = v.w; t.z = v.x; t.w = v.y; v = t; }
    if (NT) __builtin_nontemporal_store(v, (u32x4*)(dst + (size_t)r * ld + c * 8)); else *(u32x4*)(dst + (size_t)r * ld + c * 8) = v;
  }
  __syncthreads();
}

__global__ void __launch_bounds__(512, 2) fwd_kernel(Params p) {
  extern __shared__ __attribute__((aligned(16))) unsigned char smem[];
  LAS unsigned char* lds = (LAS unsigned char*)smem;
  cg::grid_group grid = cg::this_grid();
  if (p.ws == nullptr) grid.sync();
  volatile LAS unsigned* misc = (volatile LAS unsigned*)(lds + LDS_MAIN);
  if (threadIdx.x < 16) misc[threadIdx.x] = 0u;
  __syncthreads();
  const XcdBarrier gbar = xcd_barrier_post((unsigned*)(p.ws + OFF_BAR), misc);
  const int tid = threadIdx.x, lane = tid & 63, wid = __builtin_amdgcn_readfirstlane(tid >> 6), l32 = lane & 31, hi = lane >> 5;
  const int G = gridDim.x;
  const int vb = (G % 8 == 0) ? (int)((blockIdx.x % 8) * (G / 8) + blockIdx.x / 8) : (int)blockIdx.x;
  unsigned char* ws = p.ws;
  u16* xb = (u16*)(ws + OFF_XB); u16* y1 = (u16*)(ws + OFF_XB);
  float* rinv = (float*)(ws + OFF_RINV); float* rowss = (float*)(ws + OFF_ROWSS);
  float* rope = (float*)(ws + OFF_ROPE); float* tw = (float*)(ws + OFF_TW);
  u16* f1a = (u16*)(ws + OFF_F1A); u16* f1b = (u16*)(ws + OFF_F1B); u16* f2t = (u16*)(ws + OFF_F2);
  float* mf = (float*)(ws + OFF_MF);
  u16* w1t = (u16*)(ws + OFF_W1T); u16* wot = (u16*)(ws + OFF_WOT);
  u16* qb = (u16*)(ws + OFF_Q); u16* kb = (u16*)(ws + OFF_K); u16* vt = (u16*)(ws + OFF_VT);
  u16* ga = (u16*)(ws + OFF_GA); u16* gf = (u16*)(ws + OFF_GF); u16* yb = (u16*)(ws + OFF_YB);
  u16* yw = (u16*)(ws + OFF_GA);
  u16* zt = (u16*)p.out;
  unsigned* pcnt = (unsigned*)(ws + OFF_BAR) + 3584;
  const int gtid = blockIdx.x * NTHR + tid, NT_ = G * NTHR;
  const int gw = blockIdx.x * NWAVE + wid, NW = G * NWAVE;

  for (int row = gw; row < NTOK; row += NW) {
    const float* xr = (row < NPROMPT) ? p.x_prompt + (size_t)row * DM : p.x_sample + (size_t)(row - NPROMPT) * DM;
    f32x4 v[4]; float ss = 0.f;
#pragma unroll
    for (int j = 0; j < 4; ++j) { v[j] = __builtin_nontemporal_load((const f32x4*)xr + lane + 64 * j); ss += v[j].x * v[j].x + v[j].y * v[j].y + v[j].z * v[j].z + v[j].w * v[j].w; }
#pragma unroll
    for (int o = 1; o < 64; o <<= 1) ss += __shfl_xor(ss, o);
    u32x2* o8 = (u32x2*)(xb + (size_t)row * DM);
#pragma unroll
    for (int j = 0; j < 4; ++j) { u32x2 w; w.x = cvtpk(v[j].x, v[j].y); w.y = cvtpk(v[j].z, v[j].w); o8[lane + 64 * j] = w; }
    if (lane == 0) rinv[row] = rsqrtf(ss * (1.f / DM) + EPS);
  }
  for (int i = gtid; i < 8192 + 32768 + 8192; i += NT_) {
    float val; u16* dst;
    if (i < 8192 + 32768) {
      const bool big = i >= 8192; const int e = big ? i - 8192 : i; const int H = big ? 128 : 64, KS = big ? 8 : 4;
      const int j = e & 7, ln = (e >> 3) & 63, cs = (e >> 9) & 1, nt = (e >> 10) & 1, rest = e >> 11; const int ks = rest % KS, nb = rest / KS;
      const int sb = nb * 64 + nt * 32 + (ln & 31), th = ks * 16 + 8 * (j >> 2) + 4 * (ln >> 5) + (j & 3);
      float s, c; sincospif((float)((sb * th) & (H - 1)) * (2.f / (float)H), &s, &c); val = cs ? s : c; dst = (big ? f1b : f1a) + e;
    } else {
      const int e = i - 8192 - 32768; const int j = e & 7, ln = (e >> 3) & 63, nt = (e >> 9) & 1, ks = e >> 10;
      const int sa = nt * 32 + (ln & 31), kidx = ks * 16 + 8 * (ln >> 5) + j, part = kidx >> 6, tl = kidx & 63;
      float s, c; sincospif((float)((sa * tl) & 63) * (1.f / 32.f), &s, &c); val = part ? s : c; dst = f2t + e;
    }
    *dst = (u16)(cvtpk(val, 0.f) & 0xffffu);
  }
  for (int i = gtid; i < 128 * 1792; i += NT_) {
    const int k8 = i / 1792, jn = i % 1792; const int n = jn < 1280 ? jn : jn + 1024, src = jn < 1280 ? jn : jn + 512;
    float v[8];
#pragma unroll
    for (int e = 0; e < 8; ++e) v[e] = p.ln_w[k8 * 8 + e] * p.w_in[(size_t)(k8 * 8 + e) * WIN_LD + src];
    u32x4 w; w.x = cvtpk(v[0], v[1]); w.y = cvtpk(v[2], v[3]); w.z = cvtpk(v[4], v[5]); w.w = cvtpk(v[6], v[7]);
    *(u32x4*)(w1t + (size_t)n * DM + k8 * 8) = w;
  }
  for (int i = gtid; i < 128 * 1024; i += NT_) {
    const int k8 = i >> 10, n = i & 1023; float v[8];
#pragma unroll
    for (int e = 0; e < 8; ++e) v[e] = p.w_out[(size_t)(k8 * 8 + e) * DM + n];
    u32x4 w; w.x = cvtpk(v[0], v[1]); w.y = cvtpk(v[2], v[3]); w.z = cvtpk(v[4], v[5]); w.w = cvtpk(v[6], v[7]);
    *(u32x4*)(wot + (size_t)n * DM + k8 * 8) = w;
  }
  for (int i2 = gtid; i2 < 2 * 4 * 128 * 128; i2 += NT_) {
    const int which = i2 >> 16, i = i2 & 65535;
    const int c = i & 127, cp = (i >> 7) & 127, g = i >> 14; float a = 0.f;
    if (which == 0) { for (int j = 0; j < 128; ++j) a += __builtin_amdgcn_cosf((float)((cp * j) & 127) * (1.f / 128.f)) * p.w_f[(size_t)(g * 128 + j) * 128 + c]; mf[i] = a * 0.08838834764831845f; }
    else { for (int j = 0; j < 128; ++j) a += __builtin_amdgcn_sinf((float)((cp * j) & 127) * (1.f / 128.f)) * p.w_f[(size_t)(g * 128 + j) * 128 + c]; mf[65536 + i] = -a * 0.08838834764831845f; }
  }
  xcd_barrier(gbar);

  for (int u = blockIdx.x; u < 128; u += G) {
    const int g = u >> 5, d0 = (u & 31) * 32;
    LAS float* wt = (LAS float*)lds;
#pragma unroll
    for (int i = 0; i < 8; ++i) { const int idx = tid + NTHR * i, dd = idx >> 7, cc = idx & 127; wt[cc * 32 + dd] = p.w_in[(size_t)(d0 + dd) * WIN_LD + 1280 + g * 128 + cc] * p.ln_w[d0 + dd]; }
    __syncthreads();
    const int c = tid & 127, q4 = tid >> 7;
    float a1[8], a2[8];
#pragma unroll
    for (int e = 0; e < 8; ++e) { a1[e] = 0.f; a2[e] = 0.f; }
    for (int cp = 0; cp < 128; ++cp) {
      const float m1 = mf[(g * 128 + cp) * 128 + c], m2 = mf[65536 + (g * 128 + cp) * 128 + c];
      const f32x4 w0 = *(const LAS f32x4*)(wt + cp * 32 + q4 * 8), w1 = *(const LAS f32x4*)(wt + cp * 32 + q4 * 8 + 4);
      a1[0] += w0.x * m1; a1[1] += w0.y * m1; a1[2] += w0.z * m1; a1[3] += w0.w * m1; a1[4] += w1.x * m1; a1[5] += w1.y * m1; a1[6] += w1.z * m1; a1[7] += w1.w * m1;
      a2[0] += w0.x * m2; a2[1] += w0.y * m2; a2[2] += w0.z * m2; a2[3] += w0.w * m2; a2[4] += w1.x * m2; a2[5] += w1.y * m2; a2[6] += w1.z * m2; a2[7] += w1.w * m2;
    }
    u32x4 w; w.x = cvtpk(a1[0], a1[1]); w.y = cvtpk(a1[2], a1[3]); w.z = cvtpk(a1[4], a1[5]); w.w = cvtpk(a1[6], a1[7]);
    *(u32x4*)(w1t + (size_t)(1280 + g * 128 + c) * DM + d0 + q4 * 8) = w;
    w.x = cvtpk(a2[0], a2[1]); w.y = cvtpk(a2[2], a2[3]); w.z = cvtpk(a2[4], a2[5]); w.w = cvtpk(a2[6], a2[7]);
    *(u32x4*)(w1t + (size_t)(1792 + g * 128 + c) * DM + d0 + q4 * 8) = w;
    __syncthreads();
  }
  xcd_barrier(gbar);

  {
    const int wy = wid >> 2, wx = wid & 3;
    for (int u = vb; u < 192 * 11; u += G) {
      const int mt = u / 11, nt = u % 11;
      const bool swapped = !(nt >= 5 && nt < 9);
      const u16* At = xb + (size_t)mt * 256 * DM; const u16* Wt = w1t + (size_t)nt * 256 * DM;
      f32x16 acc[4][2];
#pragma unroll
      for (int a = 0; a < 4; ++a)
#pragma unroll
        for (int b = 0; b < 2; ++b) acc[a][b] = zero16();
      gemm_mainloop(lds, swapped ? Wt : At, swapped ? At : Wt, acc, tid);
      const int rowbase = mt * 256;
      int seqbase, S; seq_of_row(rowbase, seqbase, S);
      if (swapped) {
        if (nt < 2 || (nt == 2 && wy == 0)) {
          const bool isq = nt < 2;
          const float* nw = isq ? p.q_norm : p.k_norm;
          const float osc = isq ? QSCALE : 1.f;
#pragma unroll
          for (int ni = 0; ni < 2; ++ni) {
            const int token = rowbase + wx * 64 + ni * 32 + l32, pos = token - seqbase;
            const float ri = rinv[token];
#pragma unroll
            for (int hp = 0; hp < 2; ++hp) {
              float ss = 0.f;
#pragma unroll
              for (int mm = 0; mm < 2; ++mm)
#pragma unroll
                for (int r = 0; r < 16; ++r) { const float v = acc[hp * 2 + mm][ni][r] * ri; acc[hp * 2 + mm][ni][r] = v; ss += v * v; }
              ss += __shfl_xor(ss, 32);
              const float rn = rsqrtf(ss * (1.f / 64.f) + EPS);
              const int head = isq ? (nt * 4 + wy * 2 + hp) : hp;
#pragma unroll
              for (int mm = 0; mm < 2; ++mm) {
                const float posv = (float)((mm == 0) ? (pos >> 6) : (pos & 63));
#pragma unroll
                for (int r4 = 0; r4 < 4; ++r4) {
                  const int d = mm * 32 + 8 * r4 + 4 * hi;
                  const f32x4 wv = *(const f32x4*)(nw + d);
                  f32x4 cs;
                  { float pv2 = posv; asm volatile("" : "+v"(pv2));
                    const float jf = (float)(4 * r4 + 2 * hi);
                    const float rv0 = pv2 * (__builtin_amdgcn_exp2f(-0.8304820237218406f * jf) * 0.15915494309189535f), rv1 = pv2 * (__builtin_amdgcn_exp2f(-0.8304820237218406f * (jf + 1.f)) * 0.15915494309189535f);
                    cs.x = __builtin_amdgcn_cosf(rv0); cs.y = __builtin_amdgcn_sinf(rv0); cs.z = __builtin_amdgcn_cosf(rv1); cs.w = __builtin_amdgcn_sinf(rv1); }
                  const float x0 = acc[hp * 2 + mm][ni][r4 * 4 + 0] * rn * wv.x, x1 = acc[hp * 2 + mm][ni][r4 * 4 + 1] * rn * wv.y;
                  const float x2 = acc[hp * 2 + mm][ni][r4 * 4 + 2] * rn * wv.z, x3 = acc[hp * 2 + mm][ni][r4 * 4 + 3] * rn * wv.w;
                  const float o0 = (x0 * cs.x - x1 * cs.y) * osc, o1 = (x0 * cs.y + x1 * cs.x) * osc;
                  const float o2 = (x2 * cs.z - x3 * cs.w) * osc, o3 = (x2 * cs.w + x3 * cs.z) * osc;
                  u32x2 w; w.x = cvtpk(o0, o1); w.y = cvtpk(o2, o3);
                  if (isq) *(u32x2*)(qb + (size_t)token * 512 + head * 64 + d) = w;
                  else *(u32x2*)(kb + (size_t)token * 128 + head * 64 + d) = w;
                }
              }
            }
          }
        } else if (nt == 2) {
          u16* dst = vt + (size_t)seqbase * 128;
#pragma unroll
          for (int ni = 0; ni < 2; ++ni) {
            const int token = rowbase + wx * 64 + ni * 32 + l32, pos0 = token - seqbase;
            const int pos = (pos0 & ~12) | ((pos0 & 4) << 1) | ((pos0 & 8) >> 1);
            const float ri = rinv[token];
            u16* pv = dst + (size_t)(4 * hi) * S + pos;
#pragma unroll
            for (int mi = 0; mi < 4; ++mi)
#pragma unroll
              for (int r4 = 0; r4 < 4; ++r4) {
#pragma unroll
                for (int e = 0; e < 4; ++e) { *pv = (u16)(cvtpk(acc[mi][ni][r4 * 4 + e] * ri, 0.f) & 0xffffu); pv += S; asm volatile("" : "+v"(pv)); }
                pv += 4 * S; asm volatile("" : "+v"(pv));
              }
          }
        } else {
          u16* gdst = (nt < 5) ? ga : gf; const int cb = ((nt < 5) ? (nt - 3) : (nt - 9)) * 256 + wy * 128;
#pragma unroll
          for (int ni = 0; ni < 2; ++ni) {
            const int token = rowbase + wx * 64 + ni * 32 + l32; const float ri = rinv[token];
#pragma unroll
            for (int mi = 0; mi < 4; ++mi)
#pragma unroll
              for (int r4 = 0; r4 < 4; ++r4) {
                const float v0 = silu(acc[mi][ni][r4 * 4 + 0] * ri), v1 = silu(acc[mi][ni][r4 * 4 + 1] * ri), v2 = silu(acc[mi][ni][r4 * 4 + 2] * ri), v3 = silu(acc[mi][ni][r4 * 4 + 3] * ri);
                u32x2 w; w.x = cvtpk(v0, v1); w.y = cvtpk(v2, v3);
                stage_put(lds, wx * 64 + ni * 32 + l32, wy * 128 + mi * 32 + 8 * r4 + 4 * hi, w);
              }
          }
          stage_flush(lds, gdst + (size_t)rowbase * 512 + (cb - wy * 128), 512, wid, lane);
        }
      } else {
        u16* dst = zt + (size_t)seqbase * 1024 + (size_t)(nt - 5) * 256 * S;
#pragma unroll
        for (int mi = 0; mi < 4; ++mi)
#pragma unroll
          for (int r4 = 0; r4 < 4; ++r4) {
            const int token = rowbase + wy * 128 + mi * 32 + 8 * r4 + 4 * hi;
            const f32x4 ri = *(const f32x4*)(rinv + token);
#pragma unroll
            for (int ni = 0; ni < 2; ++ni) {
              const int ch = wx * 64 + ni * 32 + l32;
              u32x2 w; w.x = cvtpk(acc[mi][ni][r4 * 4 + 0] * ri.x, acc[mi][ni][r4 * 4 + 1] * ri.y); w.y = cvtpk(acc[mi][ni][r4 * 4 + 2] * ri.z, acc[mi][ni][r4 * 4 + 3] * ri.w);
              stage_put(lds, ch, wy * 128 + mi * 32 + 8 * r4 + 4 * hi, w);
            }
          }
        stage_flush(lds, dst + (rowbase - seqbase), S, wid, lane);
      }
    }
  }
  xcd_barrier(gbar);

  for (int u = gw; u < 6144; u += NW) {
    int seq, c, nb;
    if (u < 2048) { seq = 8 + (u >> 10); c = (u & 1023) >> 1; nb = u & 1; } else { const int v = u - 2048; seq = v >> 9; c = v & 511; nb = 0; }
    int seqbase, S; seq_info(seq, seqbase, S);
    const int KS = S >> 10;
    const u16* ftab = (S == 4096) ? f1a : f1b;
    const u16* zre = zt + (size_t)seqbase * 1024 + (size_t)c * S;
    const u16* zim = zre + (size_t)512 * S;
    f32x16 yr[2][2], yi[2][2];
#pragma unroll
    for (int a = 0; a < 2; ++a)
#pragma unroll
      for (int b = 0; b < 2; ++b) { yr[a][b] = zero16(); yi[a][b] = zero16(); }
    bf16x8 idf[2];
#pragma unroll
    for (int h2 = 0; h2 < 2; ++h2) { u32x4 t;
      const int b = l32 - 16 * h2 - 8 * hi;
      t.x = (b == 0 ? 0x3f80u : 0u) | (b == 1 ? 0x3f800000u : 0u); t.y = (b == 2 ? 0x3f80u : 0u) | (b == 3 ? 0x3f800000u : 0u);
      t.z = (b == 4 ? 0x3f80u : 0u) | (b == 5 ? 0x3f800000u : 0u); t.w = (b == 6 ? 0x3f80u : 0u) | (b == 7 ? 0x3f800000u : 0u);
      idf[h2] = __builtin_bit_cast(bf16x8, t); }
    for (int mt = 0; mt < (KS >> 1); ++mt) {
      bf16x8 zr[2][2], zi[2][2];
      {
        const u16* pr = zre + (size_t)(mt * 32 + l32) * 64 + 8 * hi;
        const u16* pi = zim + (size_t)(mt * 32 + l32) * 64 + 8 * hi;
        bf16x8 ar[4], ai[4];
#pragma unroll
        for (int kk = 0; kk < 4; ++kk) { ar[kk] = *(const bf16x8*)(pr + kk * 16); ai[kk] = *(const bf16x8*)(pi + kk * 16); }
#pragma unroll
        for (int nt = 0; nt < 2; ++nt) {
          f32x16 dr = __builtin_amdgcn_mfma_f32_32x32x16_bf16(ar[2 * nt], idf[0], zero16(), 0, 0, 0);
          dr = __builtin_amdgcn_mfma_f32_32x32x16_bf16(ar[2 * nt + 1], idf[1], dr, 0, 0, 0);
          f32x16 di = __builtin_amdgcn_mfma_f32_32x32x16_bf16(ai[2 * nt], idf[0], zero16(), 0, 0, 0);
          di = __builtin_amdgcn_mfma_f32_32x32x16_bf16(ai[2 * nt + 1], idf[1], di, 0, 0, 0);
#pragma unroll
          for (int k2 = 0; k2 < 2; ++k2) {
            u32x4 a, b; a.x = cvtpk(dr[k2 * 8 + 0], dr[k2 * 8 + 1]); a.y = cvtpk(dr[k2 * 8 + 2], dr[k2 * 8 + 3]); a.z = cvtpk(dr[k2 * 8 + 4], dr[k2 * 8 + 5]); a.w = cvtpk(dr[k2 * 8 + 6], dr[k2 * 8 + 7]);
            b.x = cvtpk(di[k2 * 8 + 0], di[k2 * 8 + 1]); b.y = cvtpk(di[k2 * 8 + 2], di[k2 * 8 + 3]); b.z = cvtpk(di[k2 * 8 + 4], di[k2 * 8 + 5]); b.w = cvtpk(di[k2 * 8 + 6], di[k2 * 8 + 7]);
            zr[nt][k2] = __builtin_bit_cast(bf16x8, a); zi[nt][k2] = __builtin_bit_cast(bf16x8, b);
          }
        }
      }
#pragma unroll
      for (int k2 = 0; k2 < 2; ++k2) {
        const int ks = mt * 2 + k2;
        bf16x8 fc[2], fs[2], fn[2];
#pragma unroll
        for (int ni = 0; ni < 2; ++ni) {
          const size_t fo = ((size_t)(((nb * KS + ks) * 2 + ni) * 2) * 64 + lane) * 8;
          fc[ni] = *(const bf16x8*)(ftab + fo); fs[ni] = *(const bf16x8*)(ftab + fo + 512);
          u32x4 t = __builtin_bit_cast(u32x4, fs[ni]); t.x ^= 0x80008000u; t.y ^= 0x80008000u; t.z ^= 0x80008000u; t.w ^= 0x80008000u; fn[ni] = __builtin_bit_cast(bf16x8, t);
        }
#pragma unroll
        for (int mi = 0; mi < 2; ++mi)
#pragma unroll
          for (int ni = 0; ni < 2; ++ni) {
            yr[mi][ni] = __builtin_amdgcn_mfma_f32_32x32x16_bf16(zr[mi][k2], fc[ni], yr[mi][ni], 0, 0, 0);
            yr[mi][ni] = __builtin_amdgcn_mfma_f32_32x32x16_bf16(zi[mi][k2], fs[ni], yr[mi][ni], 0, 0, 0);
            yi[mi][ni] = __builtin_amdgcn_mfma_f32_32x32x16_bf16(zi[mi][k2], fc[ni], yi[mi][ni], 0, 0, 0);
            yi[mi][ni] = __builtin_amdgcn_mfma_f32_32x32x16_bf16(zr[mi][k2], fn[ni], yi[mi][ni], 0, 0, 0);
          }
      }
    }
    const int tsh = (S == 4096) ? 1 : 0;
    u16* ybase = y1 + (size_t)seqbase * 1024;
    LAS unsigned char* wl = lds + wid * 16384;
#pragma unroll
    for (int ni = 0; ni < 2; ++ni) {
      const int sb = nb * 64 + ni * 32 + l32;
#pragma unroll
      for (int mi = 0; mi < 2; ++mi)
#pragma unroll
        for (int r4 = 0; r4 < 4; ++r4) {
          const int tl0 = mi * 32 + 8 * r4 + 4 * hi;
          float orr[4], oii[4];
#pragma unroll
          for (int e = 0; e < 4; ++e) {
            const int idx = ((sb * (tl0 + e)) << tsh) & 8191;
            const float rev = (float)idx * (1.f / 8192.f);
            const float tc = __builtin_amdgcn_cosf(rev), ts = __builtin_amdgcn_sinf(rev);
            const float a = yr[mi][ni][r4 * 4 + e], b = yi[mi][ni][r4 * 4 + e];
            orr[e] = a * tc + b * ts; oii[e] = b * tc - a * ts;
          }
          const int rl = ni * 32 + l32;
          u32x2 w; w.x = cvtpk(orr[0], orr[1]); w.y = cvtpk(orr[2], orr[3]); *(LAS u32x2*)(wl + rl * 256 + ((((tl0 >> 2)) ^ (rl & 31)) << 3)) = w;
          w.x = cvtpk(oii[0], oii[1]); w.y = cvtpk(oii[2], oii[3]); *(LAS u32x2*)(wl + rl * 256 + (((16 + (tl0 >> 2)) ^ (rl & 31)) << 3)) = w;
        }
    }
    {
      u16* yblk = ybase + ((size_t)c * (S >> 6) + nb * 64) * 128;
      const int cc = lane & 15, rq = lane >> 4;
#pragma unroll 4
      for (int rd = 0; rd < 16; ++rd) {
        const int r = rd * 4 + rq;
        u32x4 v = *(const LAS u32x4*)(wl + r * 256 + ((cc ^ ((r & 31) >> 1)) << 4));
        if (r & 1) { u32x4 t; t.x = v.z; t.y = v.w; t.z = v.x; t.w = v.y; v = t; }
        __builtin_nontemporal_store(v, (u32x4*)(yblk + (size_t)r * 128 + cc * 8));
      }
    }
  }
  xcd_barrier(gbar);

  float att_B; bool att_online;
  { float wq = fabsf(p.q_norm[lane]), wk = fabsf(p.k_norm[lane]);
#pragma unroll
    for (int o = 1; o < 64; o <<= 1) { wq = fmaxf(wq, __shfl_xor(wq, o)); wk = fmaxf(wk, __shfl_xor(wk, o)); }
    att_B = __uint_as_float(__builtin_amdgcn_readfirstlane(__float_as_uint(64.f * QSCALE * wq * wk))); att_online = !(att_B < 40.f); }
  for (int u = vb; u < 3072; u += G) {
    if (u < 1536) {
      int seq, qblk, h;
      if (u < 512) { seq = 8 + (u >> 8); const int rem = u & 255; qblk = (rem >> 2) & 31; h = (rem >> 7) * 4 + (rem & 3); } else { const int v = u - 512; seq = v >> 7; const int rem = v & 127; qblk = (rem >> 2) & 15; h = (rem >> 6) * 4 + (rem & 3); }
      int seqbase, S; seq_info(seq, seqbase, S);
      const int kvh = h >> 2, NTL = S >> 6;
      const int qtoken = seqbase + qblk * 256 + wid * 32 + l32;
      bf16x8 qf[4];
#pragma unroll
      for (int ks = 0; ks < 4; ++ks) qf[ks] = *(const bf16x8*)(qb + (size_t)qtoken * 512 + h * 64 + ks * 16 + hi * 8);
      const int c = tid & 7, r0 = tid >> 3;
      const u16* kp = kb + (size_t)(seqbase + r0) * 128 + kvh * 64 + c * 8;
      const u16* vp = vt + (size_t)seqbase * 128 + (size_t)(kvh * 64 + r0) * S + c * 8;
      const unsigned woff = r0 * 128 + ((c ^ ((r0 >> 1) & 7)) << 4);
      const int sw = (l32 >> 1) & 7;
      u32x4 kr = *(const u32x4*)kp, vr = *(const u32x4*)vp;
      *(LAS u32x4*)(lds + woff) = kr; *(LAS u32x4*)(lds + 8192 + woff) = vr;
      __syncthreads();
      f32x16 o[2]; o[0] = zero16(); o[1] = zero16();
      float m = 0.f, lsum = 0.f;
      for (int kt = 0; kt < NTL; ++kt) {
        const unsigned bo = (kt & 1) * 16384;
        if (kt + 1 < NTL) { kr = *(const u32x4*)(kp + (size_t)(kt + 1) * 64 * 128); vr = *(const u32x4*)(vp + (size_t)(kt + 1) * 64); }
        f32x16 st[2];
        bf16x8 kf[8];
#pragma unroll
        for (int ks = 0; ks < 4; ++ks) {
          const unsigned co = (unsigned)(((ks * 2 + hi) ^ sw) << 4);
#pragma unroll
          for (int mt = 0; mt < 2; ++mt) kf[ks * 2 + mt] = *(const LAS bf16x8*)(lds + bo + (mt * 32 + l32) * 128 + co);
        }
        __builtin_amdgcn_sched_barrier(0);
#pragma unroll
        for (int ks = 0; ks < 4; ++ks)
#pragma unroll
          for (int mt = 0; mt < 2; ++mt) {
            if (ks == 0) st[mt] = __builtin_amdgcn_mfma_f32_32x32x16_bf16(kf[ks * 2 + mt], qf[ks], zero16(), 0, 0, 0);
            else st[mt] = __builtin_amdgcn_mfma_f32_32x32x16_bf16(kf[ks * 2 + mt], qf[ks], st[mt], 0, 0, 0);
          }
        if (att_online) {
#pragma unroll
        for (int r = 0; r < 16; ++r) { st[0][r] -= m; st[1][r] -= m; }
        float ra = __builtin_fmaxf(__builtin_fmaxf(st[0][0], st[0][1]), st[0][2]), rb = __builtin_fmaxf(__builtin_fmaxf(st[1][0], st[1][1]), st[1][2]);
#pragma unroll
        for (int r = 3; r < 15; r += 2) { ra = __builtin_fmaxf(__builtin_fmaxf(ra, st[0][r]), st[0][r + 1]); rb = __builtin_fmaxf(__builtin_fmaxf(rb, st[1][r]), st[1][r + 1]); }
        float rm = __builtin_fmaxf(__builtin_fmaxf(ra, rb), __builtin_fmaxf(st[0][15], st[1][15]));
        { const auto rr = __builtin_amdgcn_permlane32_swap(__float_as_uint(rm), __float_as_uint(rm), false, false); rm = __builtin_fmaxf(__uint_as_float(rr[0]), __uint_as_float(rr[1])); }
        if (kt == 0 || __any(rm > 8.f)) {
          const float dl = (kt == 0) ? rm : fmaxf(rm, 0.f);
          m += dl;
          const float f = __builtin_amdgcn_exp2f(-dl);
          lsum *= f;
#pragma unroll
          for (int r = 0; r < 16; ++r) { st[0][r] -= dl; st[1][r] -= dl; o[0][r] *= f; o[1][r] *= f; }
        }
        }
        f32x2 pa = {0.f, 0.f}, pb = {0.f, 0.f};
#pragma unroll
        for (int r = 0; r < 16; r += 2) { const float e0 = __builtin_amdgcn_exp2f(st[0][r]); st[0][r] = e0; const float e1 = __builtin_amdgcn_exp2f(st[1][r]); st[1][r] = e1;
          const float e2 = __builtin_amdgcn_exp2f(st[0][r + 1]); st[0][r + 1] = e2; const float e3 = __builtin_amdgcn_exp2f(st[1][r + 1]); st[1][r + 1] = e3;
          f32x2 t0 = {e0, e2}, t1 = {e1, e3}; pa += t0; pb += t1; }
        pa += pb; lsum += pa.x + pa.y;
#pragma unroll
        for (int kk = 0; kk < 4; ++kk) {
          const int mt = kk >> 1, hb = (kk & 1) * 8;
          u32x4 pw; pw.x = cvtpk(st[mt][hb + 0], st[mt][hb + 1]); pw.y = cvtpk(st[mt][hb + 2], st[mt][hb + 3]); pw.z = cvtpk(st[mt][hb + 4], st[mt][hb + 5]); pw.w = cvtpk(st[mt][hb + 6], st[mt][hb + 7]);
          const bf16x8 pf = __builtin_bit_cast(bf16x8, pw);
          const unsigned cv = (unsigned)(((kk * 2 + hi) ^ sw) << 4);
#pragma unroll
          for (int dt = 0; dt < 2; ++dt) {
            const bf16x8 vf = *(const LAS bf16x8*)(lds + bo + 8192 + (dt * 32 + l32) * 128 + cv);
            o[dt] = __builtin_amdgcn_mfma_f32_32x32x16_bf16(vf, pf, o[dt], 0, 0, 0);
          }
        }
        if (kt + 1 < NTL) { const unsigned bn = ((kt + 1) & 1) * 16384; *(LAS u32x4*)(lds + bn + woff) = kr; *(LAS u32x4*)(lds + bn + 8192 + woff) = vr; }
        __syncthreads();
      }
      lsum += __shfl_xor(lsum, 32);
      const float inv = 1.f / lsum;
      {
        LAS unsigned char* wl = lds + 65536 + wid * 4096;
#pragma unroll
        for (int dt = 0; dt < 2; ++dt)
#pragma unroll
          for (int r4 = 0; r4 < 4; ++r4) {
            const int q = (dt * 32 + 8 * r4 + 4 * hi) >> 2;
            u32x2 w; w.x = cvtpk(o[dt][r4 * 4 + 0] * inv, o[dt][r4 * 4 + 1] * inv); w.y = cvtpk(o[dt][r4 * 4 + 2] * inv, o[dt][r4 * 4 + 3] * inv);
            *(LAS u32x2*)(wl + l32 * 128 + ((q ^ (l32 & 15)) << 3)) = w;
          }
        const int cc = lane & 7, rq = lane >> 3;
        const int tok0 = seqbase + qblk * 256 + wid * 32;
#pragma unroll
        for (int rd = 0; rd < 4; ++rd) {
          const int r = rd * 8 + rq;
          u32x4 v = *(const LAS u32x4*)(wl + r * 128 + ((cc ^ ((r & 15) >> 1)) << 4));
          if (r & 1) { u32x4 t; t.x = v.z; t.y = v.w; t.z = v.x; t.w = v.y; v = t; }
          const u32x4 g = *(const u32x4*)(ga + (size_t)(tok0 + r) * 512 + h * 64 + cc * 8);
          u32x4 w;
          w.x = cvtpk(__uint_as_float(v.x << 16) * __uint_as_float(g.x << 16), __uint_as_float(v.x & 0xffff0000u) * __uint_as_float(g.x & 0xffff0000u));
          w.y = cvtpk(__uint_as_float(v.y << 16) * __uint_as_float(g.y << 16), __uint_as_float(v.y & 0xffff0000u) * __uint_as_float(g.y & 0xffff0000u));
          w.z = cvtpk(__uint_as_float(v.z << 16) * __uint_as_float(g.z << 16), __uint_as_float(v.z & 0xffff0000u) * __uint_as_float(g.z & 0xffff0000u));
          w.w = cvtpk(__uint_as_float(v.w << 16) * __uint_as_float(g.w << 16), __uint_as_float(v.w & 0xffff0000u) * __uint_as_float(g.w & 0xffff0000u));
          *(u32x4*)(yb + (size_t)(tok0 + r) * 1024 + h * 64 + cc * 8) = w;
        }
      }
    } else {
      const int v = u - 1536; int seq, sb, gp;
      if (v < 512) { seq = 8 + (v >> 8); const int rem = v & 255; sb = rem >> 1; gp = rem & 1; } else { const int w = v - 512; seq = w >> 7; const int rem = w & 127; sb = rem >> 1; gp = rem & 1; }
      int seqbase, S; seq_info(seq, seqbase, S);
      const int H = S >> 6;
      const int cch = gp * 256 + wid * 32 + l32;
      const u16* arow = y1 + (size_t)seqbase * 1024 + ((size_t)cch * H + sb) * 128 + 8 * hi;
      f32x16 acc[2]; acc[0] = zero16(); acc[1] = zero16();
#pragma unroll
      for (int ks = 0; ks < 8; ++ks) {
        const bf16x8 af = *(const bf16x8*)(arow + ks * 16);
#pragma unroll
        for (int nt = 0; nt < 2; ++nt) {
          const bf16x8 bf = *(const bf16x8*)(f2t + ((size_t)(ks * 2 + nt) * 64 + lane) * 8);
          acc[nt] = __builtin_amdgcn_mfma_f32_32x32x16_bf16(af, bf, acc[nt], 0, 0, 0);
        }
      }
      const float nrm = (S == 4096) ? (1.f / 64.f) : 0.011048543456039806f;
      {
        LAS unsigned char* wl = lds + 65536 + wid * 4096;
#pragma unroll
        for (int nt = 0; nt < 2; ++nt) {
          const int rl = nt * 32 + l32;
#pragma unroll
          for (int r4 = 0; r4 < 4; ++r4) {
            const f32x4 bias = *(const f32x4*)(p.b_f + gp * 256 + wid * 32 + 8 * r4 + 4 * hi);
            u32x2 w; w.x = cvtpk(acc[nt][r4 * 4 + 0] * nrm + bias.x, acc[nt][r4 * 4 + 1] * nrm + bias.y); w.y = cvtpk(acc[nt][r4 * 4 + 2] * nrm + bias.z, acc[nt][r4 * 4 + 3] * nrm + bias.w);
            *(LAS u32x2*)(wl + rl * 64 + ((((8 * r4 + 4 * hi) >> 2) ^ (rl & 7)) << 3)) = w;
          }
        }
        const int cc = lane & 3, rq = lane >> 2;
#pragma unroll
        for (int rd = 0; rd < 4; ++rd) {
          const int r = rd * 16 + rq;
          const int token = seqbase + r * H + sb;
          u32x4 v = *(const LAS u32x4*)(wl + r * 64 + ((cc ^ ((r & 7) >> 1)) << 4));
          if (r & 1) { u32x4 t; t.x = v.z; t.y = v.w; t.z = v.x; t.w = v.y; v = t; }
          const int ch = gp * 256 + wid * 32 + cc * 8;
          const u32x4 g = *(const u32x4*)(gf + (size_t)token * 512 + ch);
          u32x4 w;
          w.x = cvtpk(__uint_as_float(v.x << 16) * __uint_as_float(g.x << 16), __uint_as_float(v.x & 0xffff0000u) * __uint_as_float(g.x & 0xffff0000u));
          w.y = cvtpk(__uint_as_float(v.y << 16) * __uint_as_float(g.y << 16), __uint_as_float(v.y & 0xffff0000u) * __uint_as_float(g.y & 0xffff0000u));
          w.z = cvtpk(__uint_as_float(v.z << 16) * __uint_as_float(g.z << 16), __uint_as_float(v.z & 0xffff0000u) * __uint_as_float(g.z & 0xffff0000u));
          w.w = cvtpk(__uint_as_float(v.w << 16) * __uint_as_float(g.w << 16), __uint_as_float(v.w & 0xffff0000u) * __uint_as_float(g.w & 0xffff0000u));
          *(u32x4*)(yb + (size_t)token * 1024 + 512 + ch) = w;
        }
      }
    }
  }
  xcd_barrier(gbar);

  {
    const int wy = wid >> 2, wx = wid & 3;
    for (int u = vb; u < 192 * 4; u += G) {
      const int mt = u >> 2, nt = u & 3;
      f32x16 acc[4][2];
#pragma unroll
      for (int a = 0; a < 4; ++a)
#pragma unroll
        for (int b = 0; b < 2; ++b) acc[a][b] = zero16();
      gemm_mainloop(lds, wot + (size_t)nt * 256 * DM, yb + (size_t)mt * 256 * DM, acc, tid);
#pragma unroll
      for (int ni = 0; ni < 2; ++ni) {
        const int token = mt * 256 + wx * 64 + ni * 32 + l32;
        u16* yrow = yw + (size_t)token * DM;
#pragma unroll
        for (int mi = 0; mi < 4; ++mi)
#pragma unroll
          for (int r4 = 0; r4 < 4; ++r4) {
            const int col = nt * 256 + wy * 128 + mi * 32 + 8 * r4 + 4 * hi;
            u32x2 w; w.x = cvtpk(acc[mi][ni][r4 * 4 + 0], acc[mi][ni][r4 * 4 + 1]); w.y = cvtpk(acc[mi][ni][r4 * 4 + 2], acc[mi][ni][r4 * 4 + 3]);
            stage_put(lds, wx * 64 + ni * 32 + l32, wy * 128 + mi * 32 + 8 * r4 + 4 * hi, w);
          }
      }
      stage_flush<false>(lds, yw + (size_t)mt * 256 * DM + nt * 256, DM, wid, lane);
    }
  }
  xcd_barrier(gbar);

  for (int row = gw; row < NTOK; row += NW) {
    const float* xr = (row < NPROMPT) ? p.x_prompt + (size_t)row * DM : p.x_sample + (size_t)(row - NPROMPT) * DM;
    const u32x2* yr = (const u32x2*)(yw + (size_t)row * DM);
    f32x4 v[4]; float ss = 0.f;
#pragma unroll
    for (int j = 0; j < 4; ++j) {
      const f32x4 xv = __builtin_nontemporal_load((const f32x4*)xr + lane + 64 * j); const u32x2 y = yr[lane + 64 * j];
      v[j].x = xv.x + __uint_as_float(y.x << 16); v[j].y = xv.y + __uint_as_float(y.x & 0xffff0000u); v[j].z = xv.z + __uint_as_float(y.y << 16); v[j].w = xv.w + __uint_as_float(y.y & 0xffff0000u);
      ss += v[j].x * v[j].x + v[j].y * v[j].y + v[j].z * v[j].z + v[j].w * v[j].w;
    }
#pragma unroll
    for (int o = 1; o < 64; o <<= 1) ss += __shfl_xor(ss, o);
    const float rn = rsqrtf(ss * (1.f / DM) + EPS);
    f32x4* orow = (f32x4*)(p.out + (size_t)row * DM);
#pragma unroll
    for (int j = 0; j < 4; ++j) {
      const f32x4 w = ((const f32x4*)p.final_norm)[lane + 64 * j]; f32x4 z = v[j];
      z.x *= rn * w.x; z.y *= rn * w.y; z.z *= rn * w.z; z.w *= rn * w.w; orow[lane + 64 * j] = z;
    }
  }
}

extern "C" void kernel_launch(void* const* d_in, const int* in_sizes, int n_in, void* d_out, int out_size, void* d_ws, size_t ws_size, hipStream_t stream) {
  static int grid_blocks = 0;
  if (!grid_blocks) {
    int dev = 0, cus = 0, per_cu = 0;
    hipGetDevice(&dev);
    hipDeviceGetAttribute(&cus, hipDeviceAttributeMultiprocessorCount, dev);
    hipFuncSetAttribute((const void*)fwd_kernel, hipFuncAttributeMaxDynamicSharedMemorySize, LDS_BYTES);
    hipOccupancyMaxActiveBlocksPerMultiprocessor(&per_cu, (const void*)fwd_kernel, NTHR, LDS_BYTES);
    if (per_cu < 1) per_cu = 1;
    if (per_cu > 1) per_cu = 1;
    grid_blocks = cus * per_cu;
  }
  hipMemsetAsync((char*)d_ws + OFF_BAR, 0, 16384, stream);
  Params p{};
  p.x_prompt = (const float*)d_in[0]; p.x_sample = (const float*)d_in[1]; p.ln_w = (const float*)d_in[2]; p.w_in = (const float*)d_in[3];
  p.q_norm = (const float*)d_in[4]; p.k_norm = (const float*)d_in[5]; p.w_f = (const float*)d_in[6]; p.b_f = (const float*)d_in[7];
  p.w_out = (const float*)d_in[8]; p.final_norm = (const float*)d_in[9];
  p.out = (float*)d_out; p.ws = (unsigned char*)d_ws;
  void* args[] = {&p};
  hipError_t e = hipLaunchCooperativeKernel((const void*)fwd_kernel, dim3(grid_blocks), dim3(NTHR), args, LDS_BYTES, stream);
  if (e != hipSuccess) fprintf(stderr, "cooperative launch failed: %s (grid %d)\n", hipGetErrorString(e), grid_blocks);
}
```
